# Optimizing an MI355X kernel written in HIP

```python
import math
import jax, jax.numpy as jnp
from jax import lax
import numpy as np

D_MODEL = 1024
BATCH = 4
SEQ = 4096
DEPTH = 4

EPS = 1e-6
N_BRANCH = 4
Q_BLOCK = 128

A_PATTERNS = ((128, 1), (512, 4), (2048, 16))
A_GROUPS = len(A_PATTERNS)
A_SLOTS = 6
A_HEAD_DIM = 64
A_HEADS = A_GROUPS * A_SLOTS
A_QKV = A_HEADS * A_HEAD_DIM
A_WIDTH = A_SLOTS * A_HEAD_DIM

B_WIDTH = 384
B_BLOCKS = 6
B_BLOCK_DIM = B_WIDTH // B_BLOCKS
B_CONV = 4
B_CONV_LEFT = 1
B_C = 8.0

C_HEADS = 4
C_HALF = 64
C_VDIM = 2 * C_HALF
C_QK = C_HEADS * 2 * C_HALF
C_WIDTH = C_HEADS * C_VDIM

D_HEADS = 6
D_NOPE = 64
D_ROPE = 32
D_VDIM = 64
D_QLR = 256
D_KVLR = 128
D_WIDTH = D_HEADS * D_VDIM
ROPE_BASE = 10000.0

IN_SPLITS = (
    ("a_q", A_QKV), ("a_k", A_QKV), ("a_v", A_QKV), ("a_g", A_WIDTH),
    ("b_x", B_WIDTH), ("b_g", B_WIDTH),
    ("c_q", C_QK), ("c_k", C_QK), ("c_v", C_WIDTH), ("c_g", C_WIDTH),
    ("d_cq", D_QLR), ("d_ckv", D_KVLR), ("d_kr", D_ROPE), ("d_g", D_WIDTH),
    ("gate", N_BRANCH * D_MODEL),
)
IN_WIDTH = sum(size for _, size in IN_SPLITS)

kernel_name = "hybrid_gated_parallel_mixer_encoder"


def rmsnorm(x, g):
    xf = x.astype(jnp.float32)
    y = xf * lax.rsqrt(jnp.mean(xf * xf, axis=-1, keepdims=True) + EPS)
    return (y * g.astype(jnp.float32)).astype(x.dtype)


def alibi_slopes(n):
    return jnp.asarray([2.0 ** (-8.0 * (i + 1) / n) for i in range(n)], dtype=jnp.float32)


def rope_tables(s):
    inv = ROPE_BASE ** (-jnp.arange(0, D_ROPE, 2, dtype=jnp.float32) / D_ROPE)
    ang = jnp.arange(s, dtype=jnp.float32)[:, None] * inv[None, :]
    return jnp.cos(ang), jnp.sin(ang)


def apply_rope(x, cos, sin):
    x1, x2 = jnp.split(x, 2, axis=-1)
    return jnp.concatenate([x1 * cos - x2 * sin, x1 * sin + x2 * cos], axis=-1)


def split_in(p):
    out, off = {}, 0
    for name, size in IN_SPLITS:
        out[name] = p[..., off:off + size]
        off += size
    return out


def dilated_window_attention(q, k, v, window, dilation, slopes):
    b, s, h, dh = q.shape
    n = window // (2 * dilation)
    L = s // dilation
    nb = -(-L // n)
    Lp = nb * n

    def to_sub(t):
        t = t.reshape(b, L, dilation, h, dh).transpose(0, 2, 3, 1, 4)
        return jnp.pad(t, ((0, 0), (0, 0), (0, 0), (0, Lp - L), (0, 0)))

    def neighbourhood(t):
        t = jnp.pad(to_sub(t), ((0, 0), (0, 0), (0, 0), (n, n), (0, 0)))
        t = t.reshape(b, dilation, h, nb + 2, n, dh)
        return jnp.concatenate([t[:, :, :, :-2], t[:, :, :, 1:-1], t[:, :, :, 2:]], axis=4)

    qs = to_sub(q).reshape(b, dilation, h, nb, n, dh)
    ks, vs = neighbourhood(k), neighbourhood(v)
    qi = jnp.arange(nb)[:, None] * n + jnp.arange(n)[None, :]
    ki = jnp.arange(nb)[:, None] * n - n + jnp.arange(3 * n)[None, :]
    rel = jnp.abs(ki[:, None, :] - qi[:, :, None])
    valid = (rel <= n) & (ki[:, None, :] >= 0) & (ki[:, None, :] < L)
    dist = (rel * dilation).astype(jnp.float32)
    sc = jnp.einsum("brhnqd,brhnkd->brhnqk", qs, ks) * (dh ** -0.5)
    sc = sc - slopes[:, None, None, None] * dist
    sc = jnp.where(valid, sc, -jnp.inf)
    lse = jax.nn.logsumexp(sc, axis=-1)
    o = jnp.einsum("brhnqk,brhnkd->brhnqd", jnp.exp(sc - lse[..., None]), vs)
    o = o.reshape(b, dilation, h, Lp, dh)[:, :, :, :L].transpose(0, 3, 1, 2, 4).reshape(b, s, h, dh)
    lse = lse.reshape(b, dilation, h, Lp)[..., :L].transpose(0, 3, 1, 2).reshape(b, s, h)
    return o, lse


def mixer_a(q, k, v):
    b, s, _ = q.shape
    shp = (b, s, A_GROUPS, A_SLOTS, A_HEAD_DIM)
    q, k, v = q.reshape(shp), k.reshape(shp), v.reshape(shp)
    slopes = alibi_slopes(A_SLOTS)
    outs, lses = [], []
    for g, (window, dilation) in enumerate(A_PATTERNS):
        o, l = dilated_window_attention(q[:, :, g], k[:, :, g], v[:, :, g], window, dilation, slopes)
        outs.append(o)
        lses.append(l)
    wts = jax.nn.softmax(jnp.stack(lses, axis=2), axis=2)
    o = jnp.einsum("bsgh,bsghd->bshd", wts, jnp.stack(outs, axis=2))
    return o.reshape(b, s, A_WIDTH)


def rglru_scan(xc, w_r, b_r, w_i, b_i, lam, reverse):
    b, s, w = xc.shape
    xb = xc.reshape(b, s, B_BLOCKS, B_BLOCK_DIM)
    r = jax.nn.sigmoid(jnp.einsum("bsnc,ncd->bsnd", xb, w_r).reshape(b, s, w) + b_r)
    i = jax.nn.sigmoid(jnp.einsum("bsnc,ncd->bsnd", xb, w_i).reshape(b, s, w) + b_i)
    log_a = -B_C * r * jax.nn.softplus(-lam.astype(jnp.float32))
    a = jnp.exp(log_a)
    u = jnp.sqrt(-jnp.expm1(2.0 * log_a)) * (i * xc)

    def combine(e1, e2):
        a1, u1 = e1
        a2, u2 = e2
        return a1 * a2, a2 * u1 + u2

    _, hseq = lax.associative_scan(combine, (a, u), reverse=reverse, axis=1)
    return hseq


def mixer_b(xb, conv_w, conv_b, w_r, b_r, w_i, b_i, lam):
    s = xb.shape[1]
    xp = jnp.pad(xb, ((0, 0), (B_CONV_LEFT, B_CONV - 1 - B_CONV_LEFT), (0, 0)))
    xc = conv_b + sum(xp[:, j:j + s] * conv_w[j] for j in range(B_CONV))
    h_fwd = rglru_scan(xc, w_r[0], b_r[0], w_i[0], b_i[0], lam[0], reverse=False)
    h_bwd = rglru_scan(xc, w_r[1], b_r[1], w_i[1], b_i[1], lam[1], reverse=True)
    return h_fwd + h_bwd


def mixer_c(q, k, v, lam_q1, lam_k1, lam_q2, lam_k2, subln, layer):
    b, s, _ = q.shape
    nq = s // Q_BLOCK
    q = q.reshape(b, nq, Q_BLOCK, C_HEADS, 2, C_HALF).transpose(1, 0, 2, 3, 4, 5)
    k = k.reshape(b, s, C_HEADS, 2, C_HALF)
    v = v.reshape(b, s, C_HEADS, C_VDIM)
    lam_init = 0.8 - 0.6 * math.exp(-0.3 * layer)
    lam = jnp.exp(jnp.sum(lam_q1 * lam_k1)) - jnp.exp(jnp.sum(lam_q2 * lam_k2)) + lam_init
    slopes = alibi_slopes(C_HEADS)
    pos = jnp.arange(s, dtype=jnp.float32)
    qpos = pos.reshape(nq, Q_BLOCK)

    def block(args):
        qb, qp = args
        sc = jnp.einsum("bqhcd,bkhcd->bhcqk", qb, k) * (C_HALF ** -0.5)
        sc = sc - slopes[None, :, None, None, None] * jnp.abs(qp[:, None] - pos[None, :])
        p = jax.nn.softmax(sc, axis=-1)
        return jnp.einsum("bhqk,bkhd->bqhd", p[:, :, 0] - lam * p[:, :, 1], v)

    o = lax.map(block, (q, qpos))
    o = o.transpose(1, 0, 2, 3, 4).reshape(b, s, C_HEADS, C_VDIM)
    o = rmsnorm(o, subln) * (1.0 - lam_init)
    return o.reshape(b, s, C_WIDTH)


def mixer_d(c_q, c_kv, k_rope, q_norm, kv_norm, w_uq, w_ukv, cos, sin):
    b, s, _ = c_q.shape
    nq = s // Q_BLOCK
    q = jnp.einsum("bsr,re->bse", rmsnorm(c_q, q_norm), w_uq).reshape(b, s, D_HEADS, D_NOPE + D_ROPE)
    kv = jnp.einsum("bsr,re->bse", rmsnorm(c_kv, kv_norm), w_ukv).reshape(b, s, D_HEADS, D_NOPE + D_VDIM)
    q_rope = apply_rope(q[..., D_NOPE:], cos[None, :, None], sin[None, :, None])
    k_nope, v = kv[..., :D_NOPE], kv[..., D_NOPE:]
    k_rope = apply_rope(k_rope, cos[None], sin[None])
    scale = (D_NOPE + D_ROPE) ** -0.5
    qn = q[..., :D_NOPE].reshape(b, nq, Q_BLOCK, D_HEADS, D_NOPE).transpose(1, 0, 2, 3, 4)
    qr = q_rope.reshape(b, nq, Q_BLOCK, D_HEADS, D_ROPE).transpose(1, 0, 2, 3, 4)

    def block(args):
        qnb, qrb = args
        sc = (jnp.einsum("bqhd,bkhd->bhqk", qnb, k_nope)
              + jnp.einsum("bqhr,bkr->bhqk", qrb, k_rope)) * scale
        p = jax.nn.softmax(sc, axis=-1)
        return jnp.einsum("bhqk,bkhd->bqhd", p, v)

    o = lax.map(block, (qn, qr))
    return o.transpose(1, 0, 2, 3, 4).reshape(b, s, D_WIDTH)


def setup_inputs(seed: int = 0) -> dict:
    key = jax.random.key(seed)
    ks = jax.random.split(key, 28)
    f32 = jnp.float32

    def nrm(k, shape, scale):
        return jax.random.normal(k, shape, f32) * scale

    def gain(k, shape):
        return 1.0 + 0.02 * jax.random.normal(k, shape, f32)

    a0 = jax.random.uniform(ks[11], (DEPTH, 2, B_WIDTH), f32, 0.9, 0.999)
    return {
        "x": nrm(ks[0], (BATCH, SEQ, D_MODEL), 1.0),
        "norm_pre": gain(ks[1], (DEPTH, D_MODEL)),
        "norm_post": gain(ks[2], (DEPTH, D_MODEL)),
        "w_in": nrm(ks[3], (DEPTH, D_MODEL, IN_WIDTH), D_MODEL ** -0.5),
        "conv_w": nrm(ks[4], (DEPTH, B_CONV, B_WIDTH), B_CONV ** -0.5),
        "conv_b": nrm(ks[5], (DEPTH, B_WIDTH), 0.01),
        "lru_wr": nrm(ks[6], (DEPTH, 2, B_BLOCKS, B_BLOCK_DIM, B_BLOCK_DIM), B_BLOCK_DIM ** -0.5),
        "lru_br": nrm(ks[7], (DEPTH, 2, B_WIDTH), 0.01),
        "lru_wi": nrm(ks[8], (DEPTH, 2, B_BLOCKS, B_BLOCK_DIM, B_BLOCK_DIM), B_BLOCK_DIM ** -0.5),
        "lru_bi": nrm(ks[9], (DEPTH, 2, B_WIDTH), 0.01),
        "lru_lambda": jnp.log(a0) - jnp.log1p(-a0),
        "diff_lam_q1": nrm(ks[12], (DEPTH, C_HALF), 0.1),
        "diff_lam_k1": nrm(ks[13], (DEPTH, C_HALF), 0.1),
        "diff_lam_q2": nrm(ks[14], (DEPTH, C_HALF), 0.1),
        "diff_lam_k2": nrm(ks[15], (DEPTH, C_HALF), 0.1),
        "diff_subln": gain(ks[16], (DEPTH, C_VDIM)),
        "mla_q_norm": gain(ks[17], (DEPTH, D_QLR)),
        "mla_kv_norm": gain(ks[18], (DEPTH, D_KVLR)),
        "mla_w_uq": nrm(ks[19], (DEPTH, D_QLR, D_HEADS * (D_NOPE + D_ROPE)), D_QLR ** -0.5),
        "mla_w_ukv": nrm(ks[20], (DEPTH, D_KVLR, D_HEADS * (D_NOPE + D_VDIM)), D_KVLR ** -0.5),
        "w_br_a": nrm(ks[21], (DEPTH, A_WIDTH, D_MODEL), A_WIDTH ** -0.5),
        "w_br_b": nrm(ks[22], (DEPTH, B_WIDTH, D_MODEL), B_WIDTH ** -0.5),
        "w_br_c": nrm(ks[23], (DEPTH, C_WIDTH, D_MODEL), C_WIDTH ** -0.5),
        "w_br_d": nrm(ks[24], (DEPTH, D_WIDTH, D_MODEL), D_WIDTH ** -0.5),
        "b_gate": nrm(ks[25], (DEPTH, N_BRANCH, D_MODEL), 0.01),
        "w_out": nrm(ks[26], (DEPTH, D_MODEL, D_MODEL), D_MODEL ** -0.5),
    }


def reference(x, norm_pre, norm_post, w_in, conv_w, conv_b, lru_wr, lru_br, lru_wi, lru_bi,
              lru_lambda, diff_lam_q1, diff_lam_k1, diff_lam_q2, diff_lam_k2, diff_subln,
              mla_q_norm, mla_kv_norm, mla_w_uq, mla_w_ukv, w_br_a, w_br_b, w_br_c, w_br_d,
              b_gate, w_out):
    b, s, _ = x.shape
    cos, sin = rope_tables(s)
    for l in range(DEPTH):
        h = rmsnorm(x, norm_pre[l])
        p = split_in(jnp.einsum("bsd,de->bse", h, w_in[l], preferred_element_type=jnp.float32))
        y_a = mixer_a(p["a_q"], p["a_k"], p["a_v"]) * jax.nn.silu(p["a_g"])
        y_b = mixer_b(p["b_x"], conv_w[l], conv_b[l], lru_wr[l], lru_br[l], lru_wi[l], lru_bi[l],
                      lru_lambda[l]) * jax.nn.silu(p["b_g"])
        y_c = mixer_c(p["c_q"], p["c_k"], p["c_v"], diff_lam_q1[l], diff_lam_k1[l], diff_lam_q2[l],
                      diff_lam_k2[l], diff_subln[l], l) * jax.nn.silu(p["c_g"])
        y_d = mixer_d(p["d_cq"], p["d_ckv"], p["d_kr"], mla_q_norm[l], mla_kv_norm[l], mla_w_uq[l],
                      mla_w_ukv[l], cos, sin) * jax.nn.silu(p["d_g"])
        g = jax.nn.sigmoid(p["gate"].reshape(b, s, N_BRANCH, D_MODEL) + b_gate[l])
        merged = (g[:, :, 0] * (y_a @ w_br_a[l]) + g[:, :, 1] * (y_b @ w_br_b[l])
                  + g[:, :, 2] * (y_c @ w_br_c[l]) + g[:, :, 3] * (y_d @ w_br_d[l]))
        x = x + rmsnorm(merged @ w_out[l], norm_post[l]).astype(x.dtype)
    return x
```

```cpp
#include <hip/hip_runtime.h>
#include <hip/hip_cooperative_groups.h>
#include <cstdio>
#include <cmath>
namespace cg = cooperative_groups;

#ifndef IM
#define IM 127
#endif
#ifndef ONE_LAUNCH
#define ONE_LAUNCH 1
#endif

typedef unsigned short u16;
typedef short bf16x8 __attribute__((ext_vector_type(8)));
typedef short s16x4 __attribute__((ext_vector_type(4)));
typedef float f32x4 __attribute__((ext_vector_type(4)));
typedef float f32x16 __attribute__((ext_vector_type(16)));
typedef unsigned u32x4 __attribute__((ext_vector_type(4)));
#define DI __device__ __forceinline__
#define LDSP(T, p) ((__attribute__((address_space(3))) T*)(p))

constexpr int NTOK = 16384, SEQ = 4096, DM = 1024, INW = 11552, DEPTH = 4;
constexpr int C_AQ = 0, C_AK = 1152, C_AV = 2304, C_AG = 3456, C_BX = 3840, C_BG = 4224, C_CQ = 4608, C_CK = 5120,
              C_CV = 5632, C_CG = 6144, C_DCQ = 6656, C_DCKV = 6912, C_DKR = 7040, C_DG = 7072, C_GATE = 7456;
constexpr int YW = 1664, Y_A = 0, Y_B = 384, Y_C = 768, Y_D = 1280;
constexpr float EPS = 1e-6f;
constexpr int NPHASE = 2 + 6 * DEPTH;

constexpr size_t OFF_CTR = 0;
constexpr size_t OFF_WINT = 4096;
constexpr size_t SZ_WINT = (size_t)DEPTH * 11776 * 1024 * 2;
constexpr size_t OFF_WUQT = OFF_WINT + SZ_WINT;
constexpr size_t SZ_WUQT = (size_t)DEPTH * 768 * 256 * 2;
constexpr size_t OFF_WUKVT = OFF_WUQT + SZ_WUQT;
constexpr size_t SZ_WUKVT = (size_t)DEPTH * 768 * 128 * 2;
constexpr size_t OFF_WBRT = OFF_WUKVT + SZ_WUKVT;
constexpr size_t SZ_WBRT = (size_t)DEPTH * 1024 * YW * 2;
constexpr size_t OFF_WOUTT = OFF_WBRT + SZ_WBRT;
constexpr size_t SZ_WOUTT = (size_t)DEPTH * 1024 * 1024 * 2;
constexpr size_t OFF_LRUT = OFF_WOUTT + SZ_WOUTT;
constexpr size_t SZ_LRUT = (size_t)DEPTH * 2 * 2 * 6 * 64 * 64 * 2;
constexpr size_t OFF_ROPE = OFF_LRUT + SZ_LRUT;
constexpr size_t SZ_ROPE = (size_t)SEQ * 16 * 2 * 4;
constexpr size_t OFF_HB = OFF_ROPE + SZ_ROPE;
constexpr size_t SZ_HB = (size_t)NTOK * DM * 2;
constexpr size_t OFF_P = OFF_HB + SZ_HB;
constexpr size_t SZ_P = (size_t)NTOK * INW * 2;
constexpr size_t OFF_DQ = OFF_P + SZ_P;
constexpr size_t SZ_DQ = (size_t)NTOK * 576 * 2;
constexpr size_t OFF_DK = OFF_DQ + SZ_DQ;
constexpr size_t OFF_DV = OFF_DK + SZ_DQ;
constexpr size_t SZ_DV = (size_t)NTOK * 384 * 2;
constexpr size_t OFF_AO = OFF_DV + SZ_DV;
constexpr size_t SZ_AO = (size_t)3 * NTOK * 384 * 2;
constexpr size_t OFF_ALSE = OFF_AO + SZ_AO;
constexpr size_t SZ_ALSE = (size_t)3 * NTOK * 6 * 4;
constexpr size_t OFF_SA = OFF_ALSE + SZ_ALSE;
constexpr size_t SZ_SA = (size_t)4 * 64 * 2 * 384 * 4;
constexpr size_t OFF_SU = OFF_SA + SZ_SA;
constexpr size_t OFF_Y = OFF_SU + SZ_SA;
constexpr size_t SZ_Y = (size_t)NTOK * YW * 2;
constexpr size_t WS_NEED = OFF_Y + SZ_Y;

struct Params {
  const float *x, *norm_pre, *norm_post, *w_in, *conv_w, *conv_b, *lru_wr, *lru_br, *lru_wi, *lru_bi, *lru_lambda,
      *lq1, *lk1, *lq2, *lk2, *subln, *qnorm, *kvnorm, *w_uq, *w_ukv, *w_br_a, *w_br_b, *w_br_c, *w_br_d, *b_gate, *w_out;
  float* out;
  char* ws;
  double inv[16];
  int phase_lo, phase_hi;
};

__shared__ __attribute__((aligned(1024))) char shm[147456];

DI u16 f2bf(float x) { __bf16 b = (__bf16)x; return __builtin_bit_cast(u16, b); }
DI float bf2f(u16 b) { return __uint_as_float(((unsigned)b) << 16); }
DI unsigned pack2(float a, float b) { return (unsigned)f2bf(a) | ((unsigned)f2bf(b) << 16); }
DI float sigmoidf_(float v) { return 1.f / (1.f + __expf(-v)); }
DI float siluf_(float v) { return v / (1.f + __expf(-v)); }
#define MFMA32(a, b, c) __builtin_amdgcn_mfma_f32_32x32x16_bf16((a), (b), (c), 0, 0, 0)
#define MFMA16(a, b, c) __builtin_amdgcn_mfma_f32_16x16x32_bf16((a), (b), (c), 0, 0, 0)
DI int otid() { int t = threadIdx.x; asm volatile("" : "+v"(t)); return t; }
DI int crow(int reg, int h) { return (reg & 3) + 8 * (reg >> 2) + 4 * h; }

DI int next_item(unsigned* ctr) {
  int* s = (int*)(shm + 147456 - 16);
  __syncthreads();
  if (threadIdx.x == 0) *s = (int)atomicAdd(ctr, 1u);
  __syncthreads();
  return *s;
}

DI void transpose_job(const float* __restrict__ src, int K, int N, u16* __restrict__ dst, int ldd, int koff,
                      const float* __restrict__ kscale, float cmul) {
  float(*tile)[65] = (float(*)[65])shm;
  const int ntn = (N + 63) / 64, ntk = K / 64, nt = ntn * ntk, tid = threadIdx.x;
  for (int t = blockIdx.x; t < nt; t += gridDim.x) {
    const int tk = t % ntk, tn = t / ntk, k0 = tk * 64, n0 = tn * 64;
#pragma unroll
    for (int i = 0; i < 8; ++i) {
      const int k = (tid >> 6) + 8 * i, n = n0 + (tid & 63);
      float v = (n < N) ? src[(size_t)(k0 + k) * N + n] : 0.f;
      if (kscale) v *= kscale[k0 + k];
      tile[k][tid & 63] = v * cmul;
    }
    __syncthreads();
    {
      const int n = tid >> 3, kc = (tid & 7) * 8;
      if (n0 + n < N) {
        uint4 o;
        o.x = pack2(tile[kc + 0][n], tile[kc + 1][n]);
        o.y = pack2(tile[kc + 2][n], tile[kc + 3][n]);
        o.z = pack2(tile[kc + 4][n], tile[kc + 5][n]);
        o.w = pack2(tile[kc + 6][n], tile[kc + 7][n]);
        *(uint4*)(dst + (size_t)(n0 + n) * ldd + koff + k0 + kc) = o;
      }
    }
    __syncthreads();
  }
}

DI void phase_prologue(const Params& P) {
  char* ws = P.ws;
  for (int l = 0; l < DEPTH; ++l) {
    transpose_job(P.w_in + (size_t)l * DM * INW, DM, INW, (u16*)(ws + OFF_WINT) + (size_t)l * 11776 * 1024, 1024, 0, nullptr, 1.f);
    transpose_job(P.w_uq + (size_t)l * 256 * 576, 256, 576, (u16*)(ws + OFF_WUQT) + (size_t)l * 768 * 256, 256, 0,
                  P.qnorm + l * 256, 0.10206207261596575f  );
    transpose_job(P.w_ukv + (size_t)l * 128 * 768, 128, 768, (u16*)(ws + OFF_WUKVT) + (size_t)l * 768 * 128, 128, 0,
                  P.kvnorm + l * 128, 1.f);
    u16* wbr = (u16*)(ws + OFF_WBRT) + (size_t)l * 1024 * YW;
    transpose_job(P.w_br_a + (size_t)l * 384 * DM, 384, DM, wbr, YW, Y_A, nullptr, 1.f);
    transpose_job(P.w_br_b + (size_t)l * 384 * DM, 384, DM, wbr, YW, Y_B, nullptr, 1.f);
    transpose_job(P.w_br_c + (size_t)l * 512 * DM, 512, DM, wbr, YW, Y_C, nullptr, 1.f);
    transpose_job(P.w_br_d + (size_t)l * 384 * DM, 384, DM, wbr, YW, Y_D, nullptr, 1.f);
    transpose_job(P.w_out + (size_t)l * DM * DM, DM, DM, (u16*)(ws + OFF_WOUTT) + (size_t)l * DM * DM, DM, 0, nullptr, 1.f);
  }
  const int gtid = blockIdx.x * 512 + threadIdx.x, gn = gridDim.x * 512;
  u16* lruT = (u16*)(ws + OFF_LRUT);
  for (int idx = gtid; idx < DEPTH * 2 * 2 * 6 * 4096; idx += gn) {
    const int c = idx & 63, d = (idx >> 6) & 63, n = (idx >> 12) % 6, ri = ((idx >> 12) / 6) & 1, ld = (idx >> 12) / 12;
    const float* w = ri ? P.lru_wi : P.lru_wr;
    lruT[idx] = f2bf(w[((size_t)(ld * 6 + n) * 64 + c) * 64 + d]);
  }
  float* rope = (float*)(ws + OFF_ROPE);
  for (int idx = gtid; idx < SEQ * 16; idx += gn) {
    const int pos = idx >> 4, i = idx & 15;
    double f = (double)pos * P.inv[i] * 0.15915494309189533577;
    f -= rint(f);
    rope[idx * 2] = __builtin_amdgcn_cosf((float)f);
    rope[idx * 2 + 1] = __builtin_amdgcn_sinf((float)f);
  }
}

DI float wave_sum(float v) {
#pragma unroll
  for (int o = 32; o > 0; o >>= 1) v += __shfl_xor(v, o);
  return v;
}
DI void phase_norm(const Params& P, int l) {
  const int lane = threadIdx.x & 63, gw = blockIdx.x * 8 + (threadIdx.x >> 6), nw = gridDim.x * 8;
  const float* xsrc = (l == 0) ? P.x : P.out;
  const float* oraw = (const float*)(P.ws + OFF_P);
  u16* hb = (u16*)(P.ws + OFF_HB);
  for (int row = gw; row < NTOK; row += nw) {
    float4 xv[4];
#pragma unroll
    for (int i = 0; i < 4; ++i) xv[i] = *(const float4*)(xsrc + (size_t)row * DM + lane * 4 + i * 256);
    if (l > 0) {
      float4 ov[4];
      float ss = 0.f;
#pragma unroll
      for (int i = 0; i < 4; ++i) {
        ov[i] = *(const float4*)(oraw + (size_t)row * DM + lane * 4 + i * 256);
        ss += ov[i].x * ov[i].x + ov[i].y * ov[i].y + ov[i].z * ov[i].z + ov[i].w * ov[i].w;
      }
      ss = wave_sum(ss);
      const float rs = rsqrtf(ss * (1.f / DM) + EPS);
#pragma unroll
      for (int i = 0; i < 4; ++i) {
        const float4 g = *(const float4*)(P.norm_post + (l - 1) * DM + lane * 4 + i * 256);
        xv[i].x += ov[i].x * rs * g.x; xv[i].y += ov[i].y * rs * g.y; xv[i].z += ov[i].z * rs * g.z; xv[i].w += ov[i].w * rs * g.w;
      }
    }
    if (l > 0 || true) {
#pragma unroll
      for (int i = 0; i < 4; ++i) *(float4*)(P.out + (size_t)row * DM + lane * 4 + i * 256) = xv[i];
    }
    if (l < DEPTH) {
      float ss = 0.f;
#pragma unroll
      for (int i = 0; i < 4; ++i) ss += xv[i].x * xv[i].x + xv[i].y * xv[i].y + xv[i].z * xv[i].z + xv[i].w * xv[i].w;
      ss = wave_sum(ss);
      const float rs = rsqrtf(ss * (1.f / DM) + EPS);
#pragma unroll
      for (int i = 0; i < 4; ++i) {
        const float4 g = *(const float4*)(P.norm_pre + l * DM + lane * 4 + i * 256);
        uint2 o;
        o.x = pack2(xv[i].x * rs * g.x, xv[i].y * rs * g.y);
        o.y = pack2(xv[i].z * rs * g.z, xv[i].w * rs * g.w);
        *(uint2*)(hb + (size_t)row * DM + lane * 4 + i * 256) = o;
      }
    }
  }
}

DI int lds_byte2(int r, int c) {
  int st = (r >> 4) * 2 + (c >> 5), ob = (r & 15) * 64 + (c & 31) * 2;
  return st * 1024 + (ob ^ (((ob >> 9) & 1) << 5));
}
DI void stage_rc2(int b, int& R, int& C) {
  int st = b >> 10, sb = b & 1023, swz = sb ^ (((sb >> 9) & 1) << 5);
  R = (st >> 1) * 16 + swz / 64;
  C = (st & 1) * 32 + (swz % 64) / 2;
}
#define WAIT_V0() asm volatile("s_waitcnt vmcnt(0)" ::: "memory")

template <int NF>
DI void gemm_tile(const u16* __restrict__ A, int lda, const u16* __restrict__ Bt, int ldb, int nt, f32x4 (&acc)[8][NF]) {
  constexpr int TILE_A = 32768, TILE_B = NF * 8192, STAGE_B = TILE_A + TILE_B;
  const int tid = otid(), wid = tid >> 6, lane = tid & 63, wr = wid >> 2, wc = wid & 3, fr = lane & 15, fq = lane >> 4;
  int sR[4], sC[4];
#pragma unroll
  for (int i = 0; i < 4; ++i) stage_rc2(wid * 1024 + i * 8192 + lane * 16, sR[i], sC[i]);
#define SA_(b) (shm + (b) * STAGE_B)
#define SB_(b) (shm + (b) * STAGE_B + TILE_A)
#define GSTAGE(buf, kt)                                                                                              \
  do {                                                                                                               \
    _Pragma("unroll") for (int i = 0; i < 4; ++i)                                                                    \
      __builtin_amdgcn_global_load_lds((const unsigned*)(A + (size_t)sR[i] * lda + (kt) * 64 + sC[i]),              \
                                       LDSP(unsigned, SA_(buf) + wid * 1024 + i * 8192), 16, 0, 0);                  \
    _Pragma("unroll") for (int i = 0; i < NF; ++i)                                                                   \
      __builtin_amdgcn_global_load_lds((const unsigned*)(Bt + (size_t)sR[i] * ldb + (kt) * 64 + sC[i]),             \
                                       LDSP(unsigned, SB_(buf) + wid * 1024 + i * 8192), 16, 0, 0);                  \
  } while (0)
  GSTAGE(0, 0);
  WAIT_V0();
  __syncthreads();
#pragma unroll 1
  for (int t = 0; t < nt; ++t) {
    const int cur = t & 1;
    if (t + 1 < nt) GSTAGE(cur ^ 1, t + 1);
#pragma unroll
    for (int ks = 0; ks < 2; ++ks) {
      bf16x8 At[8], Bf[NF];
#pragma unroll
      for (int m = 0; m < 8; ++m) At[m] = *(const bf16x8*)(SA_(cur) + lds_byte2(wr * 128 + m * 16 + fr, ks * 32 + fq * 8));
#pragma unroll
      for (int n = 0; n < NF; ++n) Bf[n] = *(const bf16x8*)(SB_(cur) + lds_byte2(wc * 16 * NF + n * 16 + fr, ks * 32 + fq * 8));
#pragma unroll
      for (int m = 0; m < 8; ++m)
#pragma unroll
        for (int n = 0; n < NF; ++n) acc[m][n] = MFMA16(At[m], Bf[n], acc[m][n]);
      __builtin_amdgcn_sched_barrier(0);
    }
    WAIT_V0();
    __syncthreads();
  }
#undef SA_
#undef SB_
#undef GSTAGE
}

DI void tile_remap(int t, int nM, int nN, int& pm, int& pn) {
  const int nwg = nM * nN;
  int q = nwg / 8, r = nwg % 8, xcd = t % 8, off = t / 8;
  int w = (xcd < r ? xcd * (q + 1) : r * (q + 1) + (xcd - r) * q) + off;
  int nig = 8 * nN, gid = w / nig, fm = gid * 8, gsz = min(nM - fm, 8);
  pm = fm + ((w % nig) % gsz);
  pn = (w % nig) / gsz;
}

DI void phase_inproj(const Params& P, int l) {
  const u16* hb = (const u16*)(P.ws + OFF_HB);
  const u16* wT = (const u16*)(P.ws + OFF_WINT) + (size_t)l * 11776 * 1024;
  u16* p = (u16*)(P.ws + OFF_P);
  const int tid = otid(), wid = tid >> 6, lane = tid & 63, wr = wid >> 2, wc = wid & 3, fr = lane & 15, fq = lane >> 4;
  const int nM = 64, nN = 46;
  for (int t = blockIdx.x; t < nM * nN; t += gridDim.x) {
    int pm, pn;
    tile_remap(t, nM, nN, pm, pn);
    f32x4 acc[8][4];
#pragma unroll
    for (int m = 0; m < 8; ++m)
#pragma unroll
      for (int n = 0; n < 4; ++n) acc[m][n] = f32x4{0.f, 0.f, 0.f, 0.f};
    gemm_tile<4>(hb + (size_t)pm * 256 * DM, DM, wT + (size_t)pn * 256 * DM, DM, DM / 64, acc);
#pragma unroll
    for (int n = 0; n < 4; ++n) {
      const int col0 = pn * 256 + wc * 64 + n * 16;
      if (col0 >= INW) continue;
      const int col = col0 + fr;
      int kind = 0;
      if (col0 < C_AK) kind = 1;
      else if (col0 >= C_CQ && col0 < C_CK) kind = 1;
      else if ((col0 >= C_AG && col0 < C_BX) || (col0 >= C_BG && col0 < C_CQ) || (col0 >= C_CG && col0 < C_DCQ) ||
               (col0 >= C_DG && col0 < C_GATE)) kind = 2;
      else if (col0 >= C_GATE) kind = 3;
      float bg = 0.f;
      if (kind == 3) bg = P.b_gate[l * 4096 + col - C_GATE];
#pragma unroll
      for (int m = 0; m < 8; ++m) {
#pragma unroll
        for (int j = 0; j < 4; ++j) {
          const int row = pm * 256 + wr * 128 + m * 16 + fq * 4 + j;
          float v = acc[m][n][j];
          if (kind == 1) v *= 0.125f;
          else if (kind == 2) v = siluf_(v);
          else if (kind == 3) v = sigmoidf_(v + bg);
          p[(size_t)row * INW + col] = f2bf(v);
        }
      }
    }
  }
}

template <int DQK, int DV, typename BiasF>
DI void flash_tile(const bf16x8 (&qf)[DQK / 16], const char* Kt, int KP, const char* Vt, int VP, f32x16 (&o)[DV / 32],
                   float& m, float& lsum, BiasF bias) {
  const int lane = otid() & 63, r = lane & 31, h = lane >> 5;
  f32x16 s[2];
#pragma unroll
  for (int sub = 0; sub < 2; ++sub) {
#pragma unroll
    for (int i = 0; i < 16; ++i) s[sub][i] = 0.f;
#pragma unroll
    for (int ks = 0; ks < DQK / 16; ++ks) {
      const bf16x8 kf = *(const bf16x8*)(Kt + (sub * 32 + r) * KP + ks * 32 + h * 16);
      s[sub] = MFMA32(kf, qf[ks], s[sub]);
    }
  }
  float tmax = -INFINITY;
#pragma unroll
  for (int sub = 0; sub < 2; ++sub)
#pragma unroll
    for (int i = 0; i < 16; ++i) {
      const float v = bias(sub * 32 + crow(i, h), s[sub][i]);
      s[sub][i] = v;
      tmax = fmaxf(tmax, v);
    }
  tmax = fmaxf(tmax, __shfl_xor(tmax, 32));
  const float m_new = fmaxf(m, tmax);
  const float m_safe = (m_new == -INFINITY) ? 0.f : m_new;
  const float alpha = __expf(m - m_safe);
  float psum = 0.f;
#pragma unroll
  for (int sub = 0; sub < 2; ++sub)
#pragma unroll
    for (int i = 0; i < 16; ++i) {
      const float pv = __expf(s[sub][i] - m_safe);
      s[sub][i] = pv;
      psum += pv;
    }
  psum += __shfl_xor(psum, 32);
  lsum = lsum * alpha + psum;
  m = m_new;
#pragma unroll
  for (int mt = 0; mt < DV / 32; ++mt)
#pragma unroll
    for (int i = 0; i < 16; ++i) o[mt][i] *= alpha;
  const int i16 = lane & 15, q4 = i16 >> 2, p4 = i16 & 3, blk = (lane >> 4) & 1;
#pragma unroll
  for (int kk = 0; kk < 4; ++kk) {
    const int sub = kk >> 1, s2 = kk & 1;
    u32x4 pu;
#pragma unroll
    for (int jj = 0; jj < 4; ++jj) pu[jj] = pack2(s[sub][8 * s2 + 2 * jj], s[sub][8 * s2 + 2 * jj + 1]);
    const bf16x8 pfv = __builtin_bit_cast(bf16x8, pu);
#pragma unroll
    for (int mt = 0; mt < DV / 32; ++mt) {
      const char* vb = Vt + (kk * 16 + 4 * h + q4) * VP + (mt * 32 + 16 * blk + 4 * p4) * 2;
      const s16x4 lo = __builtin_amdgcn_ds_read_tr16_b64_v4i16(LDSP(s16x4, vb));
      const s16x4 hi = __builtin_amdgcn_ds_read_tr16_b64_v4i16(LDSP(s16x4, vb + 8 * VP));
      const bf16x8 vf = __builtin_shufflevector(lo, hi, 0, 1, 2, 3, 4, 5, 6, 7);
      o[mt] = MFMA32(vf, pfv, o[mt]);
    }
  }
}

DI void a_attn_item(const Params& P, int item) {
  const u16* p = (const u16*)(P.ws + OFF_P);
  u16* Ao = (u16*)(P.ws + OFF_AO);
  float* Alse = (float*)(P.ws + OFF_ALSE);
  const int tid = otid(), lane = tid & 63, w = tid >> 6, r32 = lane & 31, h = lane >> 5;
  const int u = item * 8 + w;
  const int half = u & 1, nbr = (u >> 1) & 63, hi = u >> 7, slot = hi % 6, g = (hi / 6) % 3, b = hi / 18;
  const int dil = (g == 0) ? 1 : (g == 1 ? 4 : 16);
  const int L = SEQ / dil, res = nbr % dil, l0 = (nbr / dil) * 64;
  const float slope = exp2f(-8.f * (float)(slot + 1) / 6.f) * (float)dil;
  const int lq = l0 + half * 32 + r32;
  const size_t qrow = (size_t)b * SEQ + res + dil * lq;
  bf16x8 qf[4];
#pragma unroll
  for (int ks = 0; ks < 4; ++ks) qf[ks] = *(const bf16x8*)(p + qrow * INW + C_AQ + g * 384 + slot * 64 + ks * 16 + h * 8);
  char* Kw = shm + w * 18432;
  char* Vw = Kw + 9216;
  f32x16 o[2];
#pragma unroll
  for (int mt = 0; mt < 2; ++mt)
#pragma unroll
    for (int i = 0; i < 16; ++i) o[mt][i] = 0.f;
  float m = -INFINITY, lsum = 0.f;
  for (int kt = 0; kt < 3; ++kt) {
    const int lk0 = l0 - 64 + kt * 64;
    uint4 kv[8], vv[8];
#pragma unroll
    for (int i = 0; i < 8; ++i) {
      const int idx = lane + 64 * i, rr = idx >> 3, ch = idx & 7, lk = lk0 + rr;
      const bool valid = (lk >= 0) && (lk < L);
      const size_t krow = (size_t)b * SEQ + res + dil * (valid ? lk : 0);
      const u16* src = p + krow * INW + g * 384 + slot * 64 + ch * 8;
      kv[i] = valid ? *(const uint4*)(src + C_AK) : uint4{0, 0, 0, 0};
      vv[i] = valid ? *(const uint4*)(src + C_AV) : uint4{0, 0, 0, 0};
    }
    __builtin_amdgcn_wave_barrier();
#pragma unroll
    for (int i = 0; i < 8; ++i) {
      const int idx = lane + 64 * i, rr = idx >> 3, ch = idx & 7;
      *(uint4*)(Kw + rr * 144 + ch * 16) = kv[i];
      *(uint4*)(Vw + rr * 144 + ch * 16) = vv[i];
    }
    __builtin_amdgcn_wave_barrier();
    flash_tile<64, 64>(qf, Kw, 144, Vw, 144, o, m, lsum, [&](int key, float v) {
      const int lk = lk0 + key, rel = lk - lq, ar = rel < 0 ? -rel : rel;
      const bool ok = (ar <= 64) && (lk >= 0) && (lk < L);
      return ok ? v - slope * (float)ar : -INFINITY;
    });
    __builtin_amdgcn_wave_barrier();
  }
  const float inv = 1.f / lsum;
#pragma unroll
  for (int mt = 0; mt < 2; ++mt)
#pragma unroll
    for (int g4 = 0; g4 < 4; ++g4) {
      uint2 ov;
      ov.x = pack2(o[mt][4 * g4] * inv, o[mt][4 * g4 + 1] * inv);
      ov.y = pack2(o[mt][4 * g4 + 2] * inv, o[mt][4 * g4 + 3] * inv);
      *(uint2*)(Ao + ((size_t)g * NTOK + qrow) * 384 + slot * 64 + mt * 32 + 8 * g4 + 4 * h) = ov;
    }
  if (h == 0) Alse[((size_t)g * NTOK + qrow) * 6 + slot] = m + __logf(lsum);
}

DI void a_combine_item(const Params& P, int item) {
  const u16* p = (const u16*)(P.ws + OFF_P);
  const u16* Ao = (const u16*)(P.ws + OFF_AO);
  const float* Alse = (const float*)(P.ws + OFF_ALSE);
  u16* Y = (u16*)(P.ws + OFF_Y);
  for (int idx = otid(); idx < 128 * 48; idx += 512) {
    const size_t tok = (size_t)item * 128 + idx / 48;
    const int sc = idx % 48, slot = sc >> 3, d0 = (sc & 7) * 8;
    const float l0 = Alse[(0 * (size_t)NTOK + tok) * 6 + slot], l1 = Alse[(1 * (size_t)NTOK + tok) * 6 + slot],
                l2 = Alse[(2 * (size_t)NTOK + tok) * 6 + slot];
    const float mx = fmaxf(l0, fmaxf(l1, l2));
    float w0 = __expf(l0 - mx), w1 = __expf(l1 - mx), w2 = __expf(l2 - mx);
    const float ws_ = 1.f / (w0 + w1 + w2);
    w0 *= ws_; w1 *= ws_; w2 *= ws_;
    const uint4 a0 = *(const uint4*)(Ao + (0 * (size_t)NTOK + tok) * 384 + slot * 64 + d0);
    const uint4 a1 = *(const uint4*)(Ao + (1 * (size_t)NTOK + tok) * 384 + slot * 64 + d0);
    const uint4 a2 = *(const uint4*)(Ao + (2 * (size_t)NTOK + tok) * 384 + slot * 64 + d0);
    const uint4 gg = *(const uint4*)(p + tok * INW + C_AG + slot * 64 + d0);
    const unsigned* pa0 = (const unsigned*)&a0; const unsigned* pa1 = (const unsigned*)&a1; const unsigned* pa2 = (const unsigned*)&a2;
    const unsigned* pg = (const unsigned*)&gg;
    unsigned ov[4];
#pragma unroll
    for (int j = 0; j < 4; ++j) {
      const float lo = (w0 * bf2f(pa0[j] & 0xffff) + w1 * bf2f(pa1[j] & 0xffff) + w2 * bf2f(pa2[j] & 0xffff)) * bf2f(pg[j] & 0xffff);
      const float hi = (w0 * bf2f(pa0[j] >> 16) + w1 * bf2f(pa1[j] >> 16) + w2 * bf2f(pa2[j] >> 16)) * bf2f(pg[j] >> 16);
      ov[j] = pack2(lo, hi);
    }
    *(uint4*)(Y + tok * YW + Y_A + slot * 64 + d0) = uint4{ov[0], ov[1], ov[2], ov[3]};
  }
}

DI void b_item(const Params& P, int l, int item, int mode) {
  const u16* p = (const u16*)(P.ws + OFF_P);
  float* sA = (float*)(P.ws + OFF_SA);
  float* sU = (float*)(P.ws + OFF_SU);
  u16* Y = (u16*)(P.ws + OFF_Y);
  const u16* lruT = (const u16*)(P.ws + OFF_LRUT);
  const int tid = otid(), lane = tid & 63, w = tid >> 6;
  const int n = item % 6, ck = (item / 6) & 63, b = item / 384;
  const int t0 = ck * 64;
  float(*xs)[64] = (float(*)[64])(shm);
  float(*xcf)[64] = (float(*)[64])(shm + 17408);
  u16(*xcb)[72] = (u16(*)[72])(shm + 33792);
  float(*gt)[64][64] = (float(*)[64][64])(shm + 43008);
  float(*hs)[64][64] = (float(*)[64][64])(shm + 108544);
  for (int idx = tid; idx < 67 * 64; idx += 512) {
    const int rr = idx >> 6, c = idx & 63, t = t0 - 1 + rr;
    xs[rr][c] = (t >= 0 && t < SEQ) ? bf2f(p[((size_t)b * SEQ + t) * INW + C_BX + n * 64 + c]) : 0.f;
  }
  __syncthreads();
  for (int idx = tid; idx < 64 * 64; idx += 512) {
    const int t = idx >> 6, c = idx & 63, ch = n * 64 + c;
    const float* cw = P.conv_w + (size_t)l * 4 * 384 + ch;
    const float v = P.conv_b[l * 384 + ch] + cw[0] * xs[t][c] + cw[384] * xs[t + 1][c] + cw[768] * xs[t + 2][c] + cw[1152] * xs[t + 3][c];
    xcf[t][c] = v;
    xcb[t][c] = f2bf(v);
  }
  __syncthreads();
  {
    const int mat = w & 3, dir = mat >> 1, ri = mat & 1, th = w >> 2, r32 = lane & 31, h = lane >> 5;
    f32x16 acc[2];
#pragma unroll
    for (int nt2 = 0; nt2 < 2; ++nt2)
#pragma unroll
      for (int i = 0; i < 16; ++i) acc[nt2][i] = 0.f;
    const u16* wb = lruT + ((size_t)(((l * 2 + dir) * 2 + ri) * 6 + n) * 64) * 64;
#pragma unroll
    for (int ks = 0; ks < 4; ++ks) {
      const bf16x8 a = *(const bf16x8*)(&xcb[th * 32 + r32][ks * 16 + h * 8]);
#pragma unroll
      for (int nt2 = 0; nt2 < 2; ++nt2) {
        const bf16x8 bb = *(const bf16x8*)(wb + (size_t)(nt2 * 32 + r32) * 64 + ks * 16 + h * 8);
        acc[nt2] = MFMA32(a, bb, acc[nt2]);
      }
    }
    const float* bias = (ri ? P.lru_bi : P.lru_br) + (l * 2 + dir) * 384 + n * 64;
#pragma unroll
    for (int nt2 = 0; nt2 < 2; ++nt2) {
      const int d = nt2 * 32 + r32;
      const float bv = bias[d];
#pragma unroll
      for (int i = 0; i < 16; ++i) gt[mat][th * 32 + crow(i, h)][d] = sigmoidf_(acc[nt2][i] + bv);
    }
  }
  __syncthreads();
  for (int idx = tid; idx < 2 * 64 * 64; idx += 512) {
    const int dir = idx >> 12, t = (idx >> 6) & 63, d = idx & 63, ch = n * 64 + d;
    const float rg = gt[dir * 2][t][d], ig = gt[dir * 2 + 1][t][d];
    const float lam = P.lru_lambda[(l * 2 + dir) * 384 + ch];
    const float sp = log1pf(__expf(-lam));
    const float log_a = -8.f * rg * sp;
    const float a = __expf(log_a);
    const float u = sqrtf(fmaxf(-expm1f(2.f * log_a), 0.f)) * (ig * xcf[t][d]);
    gt[dir * 2][t][d] = a;
    gt[dir * 2 + 1][t][d] = u;
  }
  __syncthreads();
  if (tid < 128) {
    const int dir = tid >> 6, d = tid & 63, ch = n * 64 + d;
    float hcar = 0.f, pp = 1.f;
    if (mode == 1) {
      if (dir == 0) {
        for (int k = 0; k < ck; ++k) {
          const size_t si = ((size_t)(b * 64 + k) * 2 + 0) * 384 + ch;
          hcar = sA[si] * hcar + sU[si];
        }
      } else {
        for (int k = 63; k > ck; --k) {
          const size_t si = ((size_t)(b * 64 + k) * 2 + 1) * 384 + ch;
          hcar = sA[si] * hcar + sU[si];
        }
      }
    }
    if (dir == 0) {
      for (int t = 0; t < 64; ++t) {
        const float a = gt[0][t][d];
        hcar = a * hcar + gt[1][t][d];
        pp *= a;
        hs[0][t][d] = hcar;
      }
    } else {
      for (int t = 63; t >= 0; --t) {
        const float a = gt[2][t][d];
        hcar = a * hcar + gt[3][t][d];
        pp *= a;
        hs[1][t][d] = hcar;
      }
    }
    if (mode == 0) {
      const size_t si = ((size_t)(b * 64 + ck) * 2 + dir) * 384 + ch;
      sA[si] = pp;
      sU[si] = hcar;
    }
  }
  if (mode == 1) {
    __syncthreads();
    for (int idx = tid; idx < 64 * 64; idx += 512) {
      const int t = idx >> 6, c = idx & 63, ch = n * 64 + c;
      const size_t tok = (size_t)b * SEQ + t0 + t;
      const float v = (hs[0][t][c] + hs[1][t][c]) * bf2f(p[tok * INW + C_BG + ch]);
      Y[tok * YW + Y_B + ch] = f2bf(v);
    }
  }
}

template <bool isq>
DI void dprep_item(const Params& P, int l, int item) {
  const u16* p = (const u16*)(P.ws + OFF_P);
  u16* Dq = (u16*)(P.ws + OFF_DQ);
  u16* Dk = (u16*)(P.ws + OFF_DK);
  u16* Dv = (u16*)(P.ws + OFF_DV);
  const float* rope = (const float*)(P.ws + OFF_ROPE);
  const int tid = otid(), wid = tid >> 6, lane = tid & 63, wr = wid >> 2, wc = wid & 3, fr = lane & 15, fq = lane >> 4;
  const int it = item, pm = it / 3, pn = it % 3;
  constexpr int K = isq ? 256 : 128;
  const u16* A = p + (size_t)pm * 256 * INW + (isq ? C_DCQ : C_DCKV);
  const u16* Bt = (isq ? (const u16*)(P.ws + OFF_WUQT) : (const u16*)(P.ws + OFF_WUKVT)) + (size_t)l * 768 * K + (size_t)pn * 256 * K;
  float* rsq = (float*)(shm + 131072);
  {
    const int row = tid >> 1, hf = tid & 1;
    const u16* src = A + (size_t)row * INW + hf * (K / 2);
    float ss = 0.f;
    for (int c = 0; c < K / 2; c += 8) {
      const uint4 v = *(const uint4*)(src + c);
      const unsigned* pv = (const unsigned*)&v;
#pragma unroll
      for (int j = 0; j < 4; ++j) {
        const float a = bf2f(pv[j] & 0xffff), bq = bf2f(pv[j] >> 16);
        ss += a * a + bq * bq;
      }
    }
    ss += __shfl_xor(ss, 1);
    if (!hf) rsq[row] = rsqrtf(ss / (float)K + EPS);
  }
  __syncthreads();
  f32x4 acc[8][4];
#pragma unroll
  for (int m = 0; m < 8; ++m)
#pragma unroll
    for (int n = 0; n < 4; ++n) acc[m][n] = f32x4{0.f, 0.f, 0.f, 0.f};
  gemm_tile<4>(A, INW, Bt, K, K / 64, acc);
  if (isq) {
#pragma unroll
    for (int n = 0; n < 4; ++n) {
      const int col0 = pn * 256 + wc * 64 + n * 16;
      if (col0 >= 576) continue;
      const int hh = col0 / 96, e0 = col0 % 96;
      if (e0 == 80) continue;
#pragma unroll
      for (int m = 0; m < 8; ++m) {
        __builtin_amdgcn_sched_barrier(0);
#pragma unroll
        for (int j = 0; j < 4; ++j) {
          const int rl = wr * 128 + m * 16 + fq * 4 + j;
          const size_t row = (size_t)pm * 256 + rl;
          const float rs = rsq[rl];
          const float v = acc[m][n][j] * rs;
          if (e0 == 64) {
            const float x2 = acc[m][(n + 1) & 3][j] * rs;
            const int pos = (int)(row & (SEQ - 1));
            const float c = rope[(pos * 16 + fr) * 2], s = rope[(pos * 16 + fr) * 2 + 1];
            Dq[row * 576 + hh * 96 + 64 + fr] = f2bf(v * c - x2 * s);
            Dq[row * 576 + hh * 96 + 80 + fr] = f2bf(v * s + x2 * c);
          } else {
            Dq[row * 576 + hh * 96 + e0 + fr] = f2bf(v);
          }
        }
      }
    }
  } else {
#pragma unroll
    for (int n = 0; n < 4; ++n) {
      const int col0 = pn * 256 + wc * 64 + n * 16;
      const int hh = col0 / 128, e0 = col0 % 128;
#pragma unroll
      for (int m = 0; m < 8; ++m) {
        __builtin_amdgcn_sched_barrier(0);
#pragma unroll
        for (int j = 0; j < 4; ++j) {
          const int rl = wr * 128 + m * 16 + fq * 4 + j;
          const size_t row = (size_t)pm * 256 + rl;
          const float v = acc[m][n][j] * rsq[rl];
          if (e0 < 64) Dk[row * 576 + hh * 96 + e0 + fr] = f2bf(v);
          else Dv[row * 384 + hh * 64 + (e0 - 64) + fr] = f2bf(v);
        }
      }
    }
    if (pn == 0) {
      for (int idx = tid; idx < 256 * 16; idx += 512) {
        const int rl = idx >> 4, i = idx & 15;
        const size_t row = (size_t)pm * 256 + rl;
        const float x1 = bf2f(p[row * INW + C_DKR + i]), x2 = bf2f(p[row * INW + C_DKR + 16 + i]);
        const int pos = (int)(row & (SEQ - 1));
        const float c = rope[(pos * 16 + i) * 2], s = rope[(pos * 16 + i) * 2 + 1];
        const u16 o1 = f2bf(x1 * c - x2 * s), o2 = f2bf(x1 * s + x2 * c);
#pragma unroll
        for (int hh = 0; hh < 6; ++hh) {
          Dk[row * 576 + hh * 96 + 64 + i] = o1;
          Dk[row * 576 + hh * 96 + 80 + i] = o2;
        }
      }
    }
  }
}

DI void c_attn_item(const Params& P, int l, int item) {
  const u16* p = (const u16*)(P.ws + OFF_P);
  u16* Y = (u16*)(P.ws + OFF_Y);
  const int tid = otid(), lane = tid & 63, w = tid >> 6, r32 = lane & 31, h = lane >> 5;
  const int qb = item & 31, hh = (item >> 5) & 3, b = item >> 7;
  const int cmap = w >> 2, q0 = qb * 128 + (w & 3) * 32;
  const size_t qrow = (size_t)b * SEQ + q0 + r32;
  const float slope = exp2f(-2.f * (float)(hh + 1));
  bf16x8 qf[4];
#pragma unroll
  for (int ks = 0; ks < 4; ++ks) qf[ks] = *(const bf16x8*)(p + qrow * INW + C_CQ + hh * 128 + cmap * 64 + ks * 16 + h * 8);
  constexpr int KP = 272, STG = 2 * 64 * KP;
  f32x16 o[4];
#pragma unroll
  for (int mt = 0; mt < 4; ++mt)
#pragma unroll
    for (int i = 0; i < 16; ++i) o[mt][i] = 0.f;
  float m = -INFINITY, lsum = 0.f;
  const u16* kvbase = p + (size_t)b * SEQ * INW + hh * 128;
  uint4 st0, st1, st2, st3;
  const int crr = tid >> 4, cch = tid & 15;
#define gload(kt)                                                                                       \
  do {                                                                                                  \
    const u16* g0 = kvbase + (size_t)((kt) * 64 + crr) * INW + cch * 8;                                 \
    st0 = *(const uint4*)(g0 + C_CK);                                                                   \
    st1 = *(const uint4*)(g0 + (size_t)32 * INW + C_CK);                                                \
    st2 = *(const uint4*)(g0 + C_CV);                                                                   \
    st3 = *(const uint4*)(g0 + (size_t)32 * INW + C_CV);                                                \
  } while (0)
#define lstore(buf)                                                                                     \
  do {                                                                                                  \
    char* l0 = shm + (buf) * STG + crr * KP + cch * 16;                                                 \
    *(uint4*)(l0) = st0;                                                                                \
    *(uint4*)(l0 + 32 * KP) = st1;                                                                      \
    *(uint4*)(l0 + 64 * KP) = st2;                                                                      \
    *(uint4*)(l0 + 96 * KP) = st3;                                                                      \
  } while (0)
  gload(0);
  lstore(0);
  __syncthreads();
  const float qpos = (float)(q0 + r32);
  for (int kt = 0; kt < 64; ++kt) {
    const int cur = kt & 1;
    if (kt + 1 < 64) gload(kt + 1);
    const float kbase = (float)(kt * 64);
    flash_tile<64, 128>(qf, shm + cur * STG + cmap * 128, KP, shm + cur * STG + 64 * KP, KP, o, m, lsum,
                        [&](int key, float v) { return v - slope * fabsf(qpos - (kbase + (float)key)); });
    if (kt + 1 < 64) lstore(cur ^ 1);
    __syncthreads();
  }
#undef gload
#undef lstore
  float* ex = (float*)(shm + 2 * STG);
  const float inv = 1.f / lsum;
  if (cmap == 1) {
#pragma unroll
    for (int mt = 0; mt < 4; ++mt)
#pragma unroll
      for (int i = 0; i < 16; ++i) ex[((w & 3) * 64 + mt * 16 + i) * 64 + lane] = o[mt][i] * inv;
  }
  __syncthreads();
  if (cmap == 0) {
    float d1 = 0.f, d2 = 0.f;
    {
      const float a1 = P.lq1[l * 64 + lane] * P.lk1[l * 64 + lane], a2 = P.lq2[l * 64 + lane] * P.lk2[l * 64 + lane];
      d1 = wave_sum(a1);
      d2 = wave_sum(a2);
    }
    const float lam_init = 0.8f - 0.6f * expf(-0.3f * (float)l);
    const float lam = expf(d1) - expf(d2) + lam_init;
    float ss = 0.f;
#pragma unroll
    for (int mt = 0; mt < 4; ++mt)
#pragma unroll
      for (int i = 0; i < 16; ++i) {
        const float dv = o[mt][i] * inv - lam * ex[((w & 3) * 64 + mt * 16 + i) * 64 + lane];
        o[mt][i] = dv;
        ss += dv * dv;
      }
    ss += __shfl_xor(ss, 32);
    const float rs = rsqrtf(ss * (1.f / 128.f) + EPS) * (1.f - lam_init);
#pragma unroll
    for (int mt = 0; mt < 4; ++mt)
#pragma unroll
      for (int g4 = 0; g4 < 4; ++g4) {
        const int dv0 = mt * 32 + 8 * g4 + 4 * h;
        const float4 sg = *(const float4*)(P.subln + l * 128 + dv0);
        const uint2 gg = *(const uint2*)(p + qrow * INW + C_CG + hh * 128 + dv0);
        uint2 ov;
        ov.x = pack2(o[mt][4 * g4] * rs * sg.x * bf2f(gg.x & 0xffff), o[mt][4 * g4 + 1] * rs * sg.y * bf2f(gg.x >> 16));
        ov.y = pack2(o[mt][4 * g4 + 2] * rs * sg.z * bf2f(gg.y & 0xffff), o[mt][4 * g4 + 3] * rs * sg.w * bf2f(gg.y >> 16));
        *(uint2*)(Y + qrow * YW + Y_C + hh * 128 + dv0) = ov;
      }
  }
}

DI void d_attn_item(const Params& P, int item) {
  const u16* p = (const u16*)(P.ws + OFF_P);
  const u16* Dq = (const u16*)(P.ws + OFF_DQ);
  const u16* Dk = (const u16*)(P.ws + OFF_DK);
  const u16* Dv = (const u16*)(P.ws + OFF_DV);
  u16* Y = (u16*)(P.ws + OFF_Y);
  const int tid = otid(), lane = tid & 63, w = tid >> 6, r32 = lane & 31, h = lane >> 5;
  const int qb = item & 15, hh = (item >> 4) % 6, b = (item >> 4) / 6;
  const size_t qrow = (size_t)b * SEQ + qb * 256 + w * 32 + r32;
  bf16x8 qf[6];
#pragma unroll
  for (int ks = 0; ks < 6; ++ks) qf[ks] = *(const bf16x8*)(Dq + qrow * 576 + hh * 96 + ks * 16 + h * 8);
  constexpr int KP = 208, VP = 144, STG = 64 * KP + 64 * VP;
  f32x16 o[2];
#pragma unroll
  for (int mt = 0; mt < 2; ++mt)
#pragma unroll
    for (int i = 0; i < 16; ++i) o[mt][i] = 0.f;
  float m = -INFINITY, lsum = 0.f;
  const u16* kb = Dk + (size_t)b * SEQ * 576 + hh * 96;
  const u16* vb = Dv + (size_t)b * SEQ * 384 + hh * 64;
  uint4 st0, st1, st2 = uint4{0, 0, 0, 0};
  const int r0 = tid / 12, c0 = tid % 12;
  const int i1 = tid + 512, i2 = tid + 1024;
  const bool k1 = i1 < 768, has2 = i2 < 1280;
  const int r1 = k1 ? i1 / 12 : (i1 - 768) >> 3, c1 = k1 ? i1 % 12 : (i1 - 768) & 7;
  const int r2 = (i2 - 768) >> 3, c2 = (i2 - 768) & 7;
  const u16* gp0 = kb + (size_t)r0 * 576 + c0 * 8;
  const u16* gp1 = k1 ? kb + (size_t)r1 * 576 + c1 * 8 : vb + (size_t)r1 * 384 + c1 * 8;
  const size_t gs1 = k1 ? 64 * 576 : 64 * 384;
  const u16* gp2 = vb + (size_t)r2 * 384 + c2 * 8;
  const int lo0 = r0 * KP + c0 * 16, lo1 = k1 ? r1 * KP + c1 * 16 : 64 * KP + r1 * VP + c1 * 16, lo2 = 64 * KP + r2 * VP + c2 * 16;
#define gload(kt)                                                     \
  do {                                                                \
    st0 = *(const uint4*)(gp0 + (size_t)(kt) * 64 * 576);             \
    st1 = *(const uint4*)(gp1 + (size_t)(kt) * gs1);                  \
    if (has2) st2 = *(const uint4*)(gp2 + (size_t)(kt) * 64 * 384);   \
  } while (0)
#define lstore(buf)                                                   \
  do {                                                                \
    *(uint4*)(shm + (buf) * STG + lo0) = st0;                         \
    *(uint4*)(shm + (buf) * STG + lo1) = st1;                         \
    if (has2) *(uint4*)(shm + (buf) * STG + lo2) = st2;               \
  } while (0)
  gload(0);
  lstore(0);
  __syncthreads();
  for (int kt = 0; kt < 64; ++kt) {
    const int cur = kt & 1;
    if (kt + 1 < 64) gload(kt + 1);
    flash_tile<96, 64>(qf, shm + cur * STG, KP, shm + cur * STG + 64 * KP, VP, o, m, lsum, [&](int, float v) { return v; });
    if (kt + 1 < 64) lstore(cur ^ 1);
    __syncthreads();
  }
#undef gload
#undef lstore
  const float inv = 1.f / lsum;
#pragma unroll
  for (int mt = 0; mt < 2; ++mt)
#pragma unroll
    for (int g4 = 0; g4 < 4; ++g4) {
      const int dv0 = mt * 32 + 8 * g4 + 4 * h;
      const uint2 gg = *(const uint2*)(p + qrow * INW + C_DG + hh * 64 + dv0);
      uint2 ov;
      ov.x = pack2(o[mt][4 * g4] * inv * bf2f(gg.x & 0xffff), o[mt][4 * g4 + 1] * inv * bf2f(gg.x >> 16));
      ov.y = pack2(o[mt][4 * g4 + 2] * inv * bf2f(gg.y & 0xffff), o[mt][4 * g4 + 3] * inv * bf2f(gg.y >> 16));
      *(uint2*)(Y + qrow * YW + Y_D + hh * 64 + dv0) = ov;
    }
}

DI void phase_prep(const Params& P, int l) {
  unsigned* ctr = (unsigned*)(P.ws + OFF_CTR) + (l * 2 + 0);
  constexpr int N_D = 384, N_B = 1536, N_A = 1152;
  for (;;) {
    const int item = next_item(ctr);
    if (item >= N_D + N_B + N_A) break;
    if (item < 192) { if (IM & 1) dprep_item<true>(P, l, item); }
    else if (item < N_D) { if (IM & 1) dprep_item<false>(P, l, item - 192); }
    else if (item < N_D + N_B) { if (IM & 2) b_item(P, l, item - N_D, 0); }
    else { if (IM & 4) a_attn_item(P, item - N_D - N_B); }
  }
}
DI void phase_attn(const Params& P, int l) {
  unsigned* ctr = (unsigned*)(P.ws + OFF_CTR) + (l * 2 + 1);
  constexpr int N_C = 512, N_D = 384, N_B = 1536, N_A = 128;
  for (;;) {
    const int item = next_item(ctr);
    if (item >= N_C + N_D + N_B + N_A) break;
    if (item < N_C) { if (IM & 8) c_attn_item(P, l, item); }
    else if (item < N_C + N_D) { if (IM & 16) d_attn_item(P, item - N_C); }
    else if (item < N_C + N_D + N_B) { if (IM & 32) b_item(P, l, item - N_C - N_D, 1); }
    else { if (IM & 64) a_combine_item(P, item - N_C - N_D - N_B); }
  }
}

DI void phase_merge(const Params& P, int l) {
  const u16* p = (const u16*)(P.ws + OFF_P);
  const u16* Y = (const u16*)(P.ws + OFF_Y);
  const u16* wT = (const u16*)(P.ws + OFF_WBRT) + (size_t)l * 1024 * YW;
  u16* mrg = (u16*)(P.ws + OFF_HB);
  const int tid = otid(), wid = tid >> 6, lane = tid & 63, wr = wid >> 2, wc = wid & 3, fr = lane & 15, fq = lane >> 4;
  for (int t = blockIdx.x; t < 64 * 8; t += gridDim.x) {
    const int pn = t & 7, pm = t >> 3;
    f32x4 mg[8][2];
#pragma unroll
    for (int m = 0; m < 8; ++m)
#pragma unroll
      for (int n = 0; n < 2; ++n) mg[m][n] = f32x4{0.f, 0.f, 0.f, 0.f};
#pragma unroll 1
    for (int br = 0; br < 4; ++br) {
      const int koff = (br == 0) ? Y_A : (br == 1 ? Y_B : (br == 2 ? Y_C : Y_D));
      const int nk = (br == 2) ? 8 : 6;
      f32x4 acc[8][2];
#pragma unroll
      for (int m = 0; m < 8; ++m)
#pragma unroll
        for (int n = 0; n < 2; ++n) acc[m][n] = f32x4{0.f, 0.f, 0.f, 0.f};
      gemm_tile<2>(Y + (size_t)pm * 256 * YW + koff, YW, wT + (size_t)pn * 128 * YW + koff, YW, nk, acc);
#pragma unroll
      for (int m = 0; m < 8; ++m)
#pragma unroll
        for (int n = 0; n < 2; ++n)
#pragma unroll
          for (int j = 0; j < 4; ++j) {
            const size_t row = (size_t)pm * 256 + wr * 128 + m * 16 + fq * 4 + j;
            const int col = pn * 128 + wc * 32 + n * 16 + fr;
            const float g = bf2f(p[row * INW + C_GATE + br * 1024 + col]);
            mg[m][n][j] += g * acc[m][n][j];
          }
    }
#pragma unroll
    for (int m = 0; m < 8; ++m)
#pragma unroll
      for (int n = 0; n < 2; ++n)
#pragma unroll
        for (int j = 0; j < 4; ++j) {
          const size_t row = (size_t)pm * 256 + wr * 128 + m * 16 + fq * 4 + j;
          const int col = pn * 128 + wc * 32 + n * 16 + fr;
          mrg[row * DM + col] = f2bf(mg[m][n][j]);
        }
  }
}

DI void phase_outproj(const Params& P, int l) {
  const u16* mrg = (const u16*)(P.ws + OFF_HB);
  const u16* wT = (const u16*)(P.ws + OFF_WOUTT) + (size_t)l * DM * DM;
  float* oraw = (float*)(P.ws + OFF_P);
  const int tid = otid(), wid = tid >> 6, lane = tid & 63, wr = wid >> 2, wc = wid & 3, fr = lane & 15, fq = lane >> 4;
  for (int t = blockIdx.x; t < 64 * 4; t += gridDim.x) {
    const int pn = t & 3, pm = t >> 2;
    f32x4 acc[8][4];
#pragma unroll
    for (int m = 0; m < 8; ++m)
#pragma unroll
      for (int n = 0; n < 4; ++n) acc[m][n] = f32x4{0.f, 0.f, 0.f, 0.f};
    gemm_tile<4>(mrg + (size_t)pm * 256 * DM, DM, wT + (size_t)pn * 256 * DM, DM, DM / 64, acc);
#pragma unroll
    for (int m = 0; m < 8; ++m)
#pragma unroll
      for (int n = 0; n < 4; ++n)
#pragma unroll
        for (int j = 0; j < 4; ++j) {
          const size_t row = (size_t)pm * 256 + wr * 128 + m * 16 + fq * 4 + j;
          const int col = pn * 256 + wc * 64 + n * 16 + fr;
          oraw[row * DM + col] = acc[m][n][j];
        }
  }
}

__global__ void __launch_bounds__(512, 2) mixer_megakernel(Params P) {
  cg::grid_group grid = cg::this_grid();
  for (int ph = P.phase_lo; ph < P.phase_hi; ++ph) {
    if (ph > P.phase_lo) grid.sync();
#ifndef ONLY
#define ONLY -1
#endif
    if (ph == 0) { if (ONLY<0||ONLY==0) phase_prologue(P); continue; }
    if (ph == NPHASE - 1) { if (ONLY<0||ONLY==1) phase_norm(P, DEPTH); continue; }
    const int l = (ph - 1) / 6, s = (ph - 1) % 6;
    switch (s) {
      case 0: if (ONLY<0||ONLY==1) phase_norm(P, l); break;
      case 1: if (ONLY<0||ONLY==2) phase_inproj(P, l); break;
      case 2: if (ONLY<0||ONLY==3) phase_prep(P, l); break;
      case 3: if (ONLY<0||ONLY==4) phase_attn(P, l); break;
      case 4: if (ONLY<0||ONLY==5) phase_merge(P, l); break;
      default: if (ONLY<0||ONLY==6) phase_outproj(P, l); break;
    }
  }
}

extern "C" void kernel_launch(void* const* d_in, const int* in_sizes, int n_in, void* d_out, int out_size, void* d_ws,
                              size_t ws_size, hipStream_t stream) {
  (void)in_sizes; (void)n_in; (void)out_size;
  if (ws_size < WS_NEED) { fprintf(stderr, "workspace too small: %zu < %zu\n", ws_size, WS_NEED); return; }
  Params P{};
  const float** f = (const float**)&P;
  for (int i = 0; i < 26; ++i) f[i] = (const float*)d_in[i];
  P.out = (float*)d_out;
  P.ws = (char*)d_ws;
  for (int i = 0; i < 16; ++i) P.inv[i] = std::pow(10000.0, -(double)i / 16.0);
  hipMemsetAsync(d_ws, 0, 4096, stream);
#if ONE_LAUNCH
  static int grid_blocks = 0;
  if (!grid_blocks) {
    int dev = 0, cus = 0, per_cu = 0;
    hipGetDevice(&dev);
    hipDeviceGetAttribute(&cus, hipDeviceAttributeMultiprocessorCount, dev);
    hipOccupancyMaxActiveBlocksPerMultiprocessor(&per_cu, mixer_megakernel, 512, 0);
    if (per_cu < 1) per_cu = 1;
    grid_blocks = cus * per_cu;
  }
  P.phase_lo = 0;
  P.phase_hi = NPHASE;
  void* args[] = {&P};
  hipError_t e = hipLaunchCooperativeKernel((void*)mixer_megakernel, dim3(grid_blocks), dim3(512), args, 0, stream);
  if (e != hipSuccess) fprintf(stderr, "cooperative launch failed: %s (grid %d)\n", hipGetErrorString(e), grid_blocks);
#else
  for (int ph = 0; ph < NPHASE; ++ph) {
    P.phase_lo = ph;
    P.phase_hi = ph + 1;
    hipLaunchKernelGGL(mixer_megakernel, dim3(256), dim3(512), 0, stream, P);
  }
#endif
}
```

```cpp
#include <hip/hip_runtime.h>
#include <hip/hip_cooperative_groups.h>
#include <cstdio>
#include <cmath>
namespace cg = cooperative_groups;

#ifndef IM
#define IM 127
#endif
#ifndef ONE_LAUNCH
#define ONE_LAUNCH 1
#endif

typedef unsigned short u16;
typedef short bf16x8 __attribute__((ext_vector_type(8)));
typedef short s16x4 __attribute__((ext_vector_type(4)));
typedef float f32x4 __attribute__((ext_vector_type(4)));
typedef float f32x16 __attribute__((ext_vector_type(16)));
typedef unsigned u32x4 __attribute__((ext_vector_type(4)));
#define DI __device__ __forceinline__
#define LDSP(T, p) ((__attribute__((address_space(3))) T*)(p))

constexpr int NTOK = 16384, SEQ = 4096, DM = 1024, INW = 11552, DEPTH = 4;
constexpr int C_AQ = 0, C_AK = 1152, C_AV = 2304, C_AG = 3456, C_BX = 3840, C_BG = 4224, C_CQ = 4608, C_CK = 5120,
              C_CV = 5632, C_CG = 6144, C_DCQ = 6656, C_DCKV = 6912, C_DKR = 7040, C_DG = 7072, C_GATE = 7456;
constexpr int YW = 1664, Y_A = 0, Y_B = 384, Y_C = 768, Y_D = 1280;
constexpr float EPS = 1e-6f;
constexpr float LOG2E = 1.4426950408889634f, QSC = 0.125f * 1.4426950408889634f;
constexpr int NPHASE = 2 + 6 * DEPTH;

constexpr size_t OFF_CTR = 0;
constexpr size_t OFF_WINT = 4096;
constexpr size_t SZ_WINT = (size_t)DEPTH * 11776 * 1024 * 2;
constexpr size_t OFF_WUQT = OFF_WINT + SZ_WINT;
constexpr size_t SZ_WUQT = (size_t)DEPTH * 768 * 256 * 2;
constexpr size_t OFF_WUKVT = OFF_WUQT + SZ_WUQT;
constexpr size_t SZ_WUKVT = (size_t)DEPTH * 768 * 128 * 2;
constexpr size_t OFF_WBRT = OFF_WUKVT + SZ_WUKVT;
constexpr size_t SZ_WBRT = (size_t)DEPTH * 1024 * YW * 2;
constexpr size_t OFF_WOUTT = OFF_WBRT + SZ_WBRT;
constexpr size_t SZ_WOUTT = (size_t)DEPTH * 1024 * 1024 * 2;
constexpr size_t OFF_LRUT = OFF_WOUTT + SZ_WOUTT;
constexpr size_t SZ_LRUT = (size_t)DEPTH * 2 * 2 * 6 * 64 * 64 * 2;
constexpr size_t OFF_ROPE = OFF_LRUT + SZ_LRUT;
constexpr size_t SZ_ROPE = (size_t)SEQ * 16 * 2 * 4;
constexpr size_t OFF_HB = OFF_ROPE + SZ_ROPE;
constexpr size_t SZ_HB = (size_t)NTOK * DM * 2;
constexpr size_t OFF_P = OFF_HB + SZ_HB;
constexpr size_t SZ_P = (size_t)NTOK * INW * 2;
constexpr size_t OFF_DQ = OFF_P + SZ_P;
constexpr size_t SZ_DQ = (size_t)NTOK * 576 * 2;
constexpr size_t OFF_DK = OFF_DQ + SZ_DQ;
constexpr size_t OFF_DV = OFF_DK + SZ_DQ;
constexpr size_t SZ_DV = (size_t)NTOK * 384 * 2;
constexpr size_t OFF_AO = OFF_DV + SZ_DV;
constexpr size_t SZ_AO = (size_t)3 * NTOK * 384 * 2;
constexpr size_t OFF_ALSE = OFF_AO + SZ_AO;
constexpr size_t SZ_ALSE = (size_t)3 * NTOK * 6 * 4;
constexpr size_t OFF_SA = OFF_ALSE + SZ_ALSE;
constexpr size_t SZ_SA = (size_t)4 * 64 * 2 * 384 * 4;
constexpr size_t OFF_SU = OFF_SA + SZ_SA;
constexpr size_t OFF_Y = OFF_SU + SZ_SA;
constexpr size_t SZ_Y = (size_t)NTOK * YW * 2;
constexpr size_t WS_NEED = OFF_Y + SZ_Y;

struct Params {
  const float *x, *norm_pre, *norm_post, *w_in, *conv_w, *conv_b, *lru_wr, *lru_br, *lru_wi, *lru_bi, *lru_lambda,
      *lq1, *lk1, *lq2, *lk2, *subln, *qnorm, *kvnorm, *w_uq, *w_ukv, *w_br_a, *w_br_b, *w_br_c, *w_br_d, *b_gate, *w_out;
  float* out;
  char* ws;
  double inv[16];
  int phase_lo, phase_hi;
};

__shared__ __attribute__((aligned(1024))) char shm[147456];

DI u16 f2bf(float x) { __bf16 b = (__bf16)x; return __builtin_bit_cast(u16, b); }
DI float bf2f(u16 b) { return __uint_as_float(((unsigned)b) << 16); }
DI unsigned pack2(float a, float b) { return (unsigned)f2bf(a) | ((unsigned)f2bf(b) << 16); }
DI float sigmoidf_(float v) { return 1.f / (1.f + __expf(-v)); }
DI float siluf_(float v) { return v / (1.f + __expf(-v)); }
#define MFMA32(a, b, c) __builtin_amdgcn_mfma_f32_32x32x16_bf16((a), (b), (c), 0, 0, 0)
#define MFMA16(a, b, c) __builtin_amdgcn_mfma_f32_16x16x32_bf16((a), (b), (c), 0, 0, 0)
DI int otid() { int t = threadIdx.x; asm volatile("" : "+v"(t)); return t; }
DI int crow(int reg, int h) { return (reg & 3) + 8 * (reg >> 2) + 4 * h; }

DI int next_item(unsigned* ctr) {
  int* s = (int*)(shm + 147456 - 16);
  __syncthreads();
  if (threadIdx.x == 0) *s = (int)atomicAdd(ctr, 1u);
  __syncthreads();
  return *s;
}

DI void transpose_job(const float* __restrict__ src, int K, int N, u16* __restrict__ dst, int ldd, int koff,
                      const float* __restrict__ kscale, float cmul) {
  float(*tile)[65] = (float(*)[65])shm;
  const int ntn = (N + 63) / 64, ntk = K / 64, nt = ntn * ntk, tid = threadIdx.x;
  for (int t = blockIdx.x; t < nt; t += gridDim.x) {
    const int tk = t % ntk, tn = t / ntk, k0 = tk * 64, n0 = tn * 64;
#pragma unroll
    for (int i = 0; i < 8; ++i) {
      const int k = (tid >> 6) + 8 * i, n = n0 + (tid & 63);
      float v = (n < N) ? src[(size_t)(k0 + k) * N + n] : 0.f;
      if (kscale) v *= kscale[k0 + k];
      tile[k][tid & 63] = v * cmul;
    }
    __syncthreads();
    {
      const int n = tid >> 3, kc = (tid & 7) * 8;
      if (n0 + n < N) {
        uint4 o;
        o.x = pack2(tile[kc + 0][n], tile[kc + 1][n]);
        o.y = pack2(tile[kc + 2][n], tile[kc + 3][n]);
        o.z = pack2(tile[kc + 4][n], tile[kc + 5][n]);
        o.w = pack2(tile[kc + 6][n], tile[kc + 7][n]);
        *(uint4*)(dst + (size_t)(n0 + n) * ldd + koff + k0 + kc) = o;
      }
    }
    __syncthreads();
  }
}

DI void phase_prologue(const Params& P) {
  char* ws = P.ws;
  for (int l = 0; l < DEPTH; ++l) {
    transpose_job(P.w_in + (size_t)l * DM * INW, DM, INW, (u16*)(ws + OFF_WINT) + (size_t)l * 11776 * 1024, 1024, 0, nullptr, 1.f);
    transpose_job(P.w_uq + (size_t)l * 256 * 576, 256, 576, (u16*)(ws + OFF_WUQT) + (size_t)l * 768 * 256, 256, 0,
                  P.qnorm + l * 256, 0.10206207261596575f * LOG2E  );
    transpose_job(P.w_ukv + (size_t)l * 128 * 768, 128, 768, (u16*)(ws + OFF_WUKVT) + (size_t)l * 768 * 128, 128, 0,
                  P.kvnorm + l * 128, 1.f);
    u16* wbr = (u16*)(ws + OFF_WBRT) + (size_t)l * 1024 * YW;
    transpose_job(P.w_br_a + (size_t)l * 384 * DM, 384, DM, wbr, YW, Y_A, nullptr, 1.f);
    transpose_job(P.w_br_b + (size_t)l * 384 * DM, 384, DM, wbr, YW, Y_B, nullptr, 1.f);
    transpose_job(P.w_br_c + (size_t)l * 512 * DM, 512, DM, wbr, YW, Y_C, nullptr, 1.f);
    transpose_job(P.w_br_d + (size_t)l * 384 * DM, 384, DM, wbr, YW, Y_D, nullptr, 1.f);
    transpose_job(P.w_out + (size_t)l * DM * DM, DM, DM, (u16*)(ws + OFF_WOUTT) + (size_t)l * DM * DM, DM, 0, nullptr, 1.f);
  }
  const int gtid = blockIdx.x * 512 + threadIdx.x, gn = gridDim.x * 512;
  u16* lruT = (u16*)(ws + OFF_LRUT);
  for (int idx = gtid; idx < DEPTH * 2 * 2 * 6 * 4096; idx += gn) {
    const int c = idx & 63, d = (idx >> 6) & 63, n = (idx >> 12) % 6, ri = ((idx >> 12) / 6) & 1, ld = (idx >> 12) / 12;
    const float* w = ri ? P.lru_wi : P.lru_wr;
    lruT[idx] = f2bf(w[((size_t)(ld * 6 + n) * 64 + c) * 64 + d]);
  }
  float* rope = (float*)(ws + OFF_ROPE);
  for (int idx = gtid; idx < SEQ * 16; idx += gn) {
    const int pos = idx >> 4, i = idx & 15;
    double f = (double)pos * P.inv[i] * 0.15915494309189533577;
    f -= rint(f);
    rope[idx * 2] = __builtin_amdgcn_cosf((float)f);
    rope[idx * 2 + 1] = __builtin_amdgcn_sinf((float)f);
  }
}

DI float wave_sum(float v) {
#pragma unroll
  for (int o = 32; o > 0; o >>= 1) v += __shfl_xor(v, o);
  return v;
}
DI void phase_norm(const Params& P, int l) {
  const int lane = threadIdx.x & 63, gw = blockIdx.x * 8 + (threadIdx.x >> 6), nw = gridDim.x * 8;
  const float* xsrc = (l == 0) ? P.x : P.out;
  const float* oraw = (const float*)(P.ws + OFF_P);
  u16* hb = (u16*)(P.ws + OFF_HB);
  for (int row = gw; row < NTOK; row += nw) {
    float4 xv[4];
#pragma unroll
    for (int i = 0; i < 4; ++i) xv[i] = *(const float4*)(xsrc + (size_t)row * DM + lane * 4 + i * 256);
    if (l > 0) {
      float4 ov[4];
      float ss = 0.f;
#pragma unroll
      for (int i = 0; i < 4; ++i) {
        ov[i] = *(const float4*)(oraw + (size_t)row * DM + lane * 4 + i * 256);
        ss += ov[i].x * ov[i].x + ov[i].y * ov[i].y + ov[i].z * ov[i].z + ov[i].w * ov[i].w;
      }
      ss = wave_sum(ss);
      const float rs = rsqrtf(ss * (1.f / DM) + EPS);
#pragma unroll
      for (int i = 0; i < 4; ++i) {
        const float4 g = *(const float4*)(P.norm_post + (l - 1) * DM + lane * 4 + i * 256);
        xv[i].x += ov[i].x * rs * g.x; xv[i].y += ov[i].y * rs * g.y; xv[i].z += ov[i].z * rs * g.z; xv[i].w += ov[i].w * rs * g.w;
      }
    }
    if (l > 0 || true) {
#pragma unroll
      for (int i = 0; i < 4; ++i) *(float4*)(P.out + (size_t)row * DM + lane * 4 + i * 256) = xv[i];
    }
    if (l < DEPTH) {
      float ss = 0.f;
#pragma unroll
      for (int i = 0; i < 4; ++i) ss += xv[i].x * xv[i].x + xv[i].y * xv[i].y + xv[i].z * xv[i].z + xv[i].w * xv[i].w;
      ss = wave_sum(ss);
      const float rs = rsqrtf(ss * (1.f / DM) + EPS);
#pragma unroll
      for (int i = 0; i < 4; ++i) {
        const float4 g = *(const float4*)(P.norm_pre + l * DM + lane * 4 + i * 256);
        uint2 o;
        o.x = pack2(xv[i].x * rs * g.x, xv[i].y * rs * g.y);
        o.y = pack2(xv[i].z * rs * g.z, xv[i].w * rs * g.w);
        *(uint2*)(hb + (size_t)row * DM + lane * 4 + i * 256) = o;
      }
    }
  }
}

DI int lds_byte2(int r, int c) {
  int st = (r >> 4) * 2 + (c >> 5), ob = (r & 15) * 64 + (c & 31) * 2;
  return st * 1024 + (ob ^ (((ob >> 9) & 1) << 5));
}
DI void stage_rc2(int b, int& R, int& C) {
  int st = b >> 10, sb = b & 1023, swz = sb ^ (((sb >> 9) & 1) << 5);
  R = (st >> 1) * 16 + swz / 64;
  C = (st & 1) * 32 + (swz % 64) / 2;
}
#define WAIT_V0() asm volatile("s_waitcnt vmcnt(0)" ::: "memory")

template <int NF>
DI void gemm_tile(const u16* __restrict__ A, int lda, const u16* __restrict__ Bt, int ldb, int nt, f32x4 (&acc)[8][NF]) {
  constexpr int TILE_A = 32768, TILE_B = NF * 8192, STAGE_B = TILE_A + TILE_B;
  const int tid = otid(), wid = tid >> 6, lane = tid & 63, wr = wid >> 2, wc = wid & 3, fr = lane & 15, fq = lane >> 4;
  int sR[4], sC[4];
#pragma unroll
  for (int i = 0; i < 4; ++i) stage_rc2(wid * 1024 + i * 8192 + lane * 16, sR[i], sC[i]);
#define SA_(b) (shm + (b) * STAGE_B)
#define SB_(b) (shm + (b) * STAGE_B + TILE_A)
#define GSTAGE(buf, kt)                                                                                              \
  do {                                                                                                               \
    _Pragma("unroll") for (int i = 0; i < 4; ++i)                                                                    \
      __builtin_amdgcn_global_load_lds((const unsigned*)(A + (size_t)sR[i] * lda + (kt) * 64 + sC[i]),              \
                                       LDSP(unsigned, SA_(buf) + wid * 1024 + i * 8192), 16, 0, 0);                  \
    _Pragma("unroll") for (int i = 0; i < NF; ++i)                                                                   \
      __builtin_amdgcn_global_load_lds((const unsigned*)(Bt + (size_t)sR[i] * ldb + (kt) * 64 + sC[i]),             \
                                       LDSP(unsigned, SB_(buf) + wid * 1024 + i * 8192), 16, 0, 0);                  \
  } while (0)
  GSTAGE(0, 0);
  WAIT_V0();
  __syncthreads();
#pragma unroll 1
  for (int t = 0; t < nt; ++t) {
    const int cur = t & 1;
    if (t + 1 < nt) GSTAGE(cur ^ 1, t + 1);
#pragma unroll
    for (int ks = 0; ks < 2; ++ks) {
      bf16x8 At[8], Bf[NF];
#pragma unroll
      for (int m = 0; m < 8; ++m) At[m] = *(const bf16x8*)(SA_(cur) + lds_byte2(wr * 128 + m * 16 + fr, ks * 32 + fq * 8));
#pragma unroll
      for (int n = 0; n < NF; ++n) Bf[n] = *(const bf16x8*)(SB_(cur) + lds_byte2(wc * 16 * NF + n * 16 + fr, ks * 32 + fq * 8));
#pragma unroll
      for (int m = 0; m < 8; ++m)
#pragma unroll
        for (int n = 0; n < NF; ++n) acc[m][n] = MFMA16(Bf[n], At[m], acc[m][n]);
      __builtin_amdgcn_sched_barrier(0);
    }
    WAIT_V0();
    __syncthreads();
  }
#undef SA_
#undef SB_
#undef GSTAGE
}

DI void tile_remap(int t, int nM, int nN, int& pm, int& pn) {
  const int nwg = nM * nN;
  int q = nwg / 8, r = nwg % 8, xcd = t % 8, off = t / 8;
  int w = (xcd < r ? xcd * (q + 1) : r * (q + 1) + (xcd - r) * q) + off;
  int nig = 8 * nN, gid = w / nig, fm = gid * 8, gsz = min(nM - fm, 8);
  pm = fm + ((w % nig) % gsz);
  pn = (w % nig) / gsz;
}

DI void phase_inproj(const Params& P, int l) {
  const u16* hb = (const u16*)(P.ws + OFF_HB);
  const u16* wT = (const u16*)(P.ws + OFF_WINT) + (size_t)l * 11776 * 1024;
  u16* p = (u16*)(P.ws + OFF_P);
  const int tid = otid(), wid = tid >> 6, lane = tid & 63, wr = wid >> 2, wc = wid & 3, fr = lane & 15, fq = lane >> 4;
  const int nM = 64, nN = 46;
  for (int t = blockIdx.x; t < nM * nN; t += gridDim.x) {
    int pm, pn;
    tile_remap(t, nM, nN, pm, pn);
    f32x4 acc[8][4];
#pragma unroll
    for (int m = 0; m < 8; ++m)
#pragma unroll
      for (int n = 0; n < 4; ++n) acc[m][n] = f32x4{0.f, 0.f, 0.f, 0.f};
    gemm_tile<4>(hb + (size_t)pm * 256 * DM, DM, wT + (size_t)pn * 256 * DM, DM, DM / 64, acc);
#pragma unroll
    for (int n = 0; n < 4; ++n) {
      const int col0 = pn * 256 + wc * 64 + n * 16;
      if (col0 >= INW) continue;
      int kind = 0;
      if (col0 < C_AK) kind = 1;
      else if (col0 >= C_CQ && col0 < C_CK) kind = 1;
      else if ((col0 >= C_AG && col0 < C_BX) || (col0 >= C_BG && col0 < C_CQ) || (col0 >= C_CG && col0 < C_DCQ) ||
               (col0 >= C_DG && col0 < C_GATE)) kind = 2;
      else if (col0 >= C_GATE) kind = 3;
      float4 bg = float4{0.f, 0.f, 0.f, 0.f};
      if (kind == 3) bg = *(const float4*)(P.b_gate + l * 4096 + col0 - C_GATE + fq * 4);
#pragma unroll
      for (int m = 0; m < 8; ++m) {
        const size_t row = (size_t)pm * 256 + wr * 128 + m * 16 + fr;
        float v0 = acc[m][n][0], v1 = acc[m][n][1], v2 = acc[m][n][2], v3 = acc[m][n][3];
        if (kind == 1) { v0 *= QSC; v1 *= QSC; v2 *= QSC; v3 *= QSC; }
        else if (kind == 2) { v0 = siluf_(v0); v1 = siluf_(v1); v2 = siluf_(v2); v3 = siluf_(v3); }
        else if (kind == 3) { v0 = sigmoidf_(v0 + bg.x); v1 = sigmoidf_(v1 + bg.y); v2 = sigmoidf_(v2 + bg.z); v3 = sigmoidf_(v3 + bg.w); }
        *(uint2*)(p + row * INW + col0 + fq * 4) = uint2{pack2(v0, v1), pack2(v2, v3)};
      }
    }
  }
}

DI float half_max(float x) {
  auto r = __builtin_amdgcn_permlane32_swap(__float_as_uint(x), __float_as_uint(x), false, false);
  return fmaxf(__uint_as_float(r[0]), __uint_as_float(r[1]));
}
DI float half_sum(float x) {
  auto r = __builtin_amdgcn_permlane32_swap(__float_as_uint(x), __float_as_uint(x), false, false);
  return __uint_as_float(r[0]) + __uint_as_float(r[1]);
}
template <int DQK, int DV, typename BiasF>
DI void flash_tile(const bf16x8 (&qf)[DQK / 16], const char* Kt, int KP, const char* Vt, int VP, f32x16 (&o)[DV / 32],
                   float& m, float& lsum, BiasF bias) {
  const int lane = otid() & 63, r = lane & 31, h = lane >> 5;
  f32x16 s[2];
#pragma unroll
  for (int sub = 0; sub < 2; ++sub) {
#pragma unroll
    for (int i = 0; i < 16; ++i) s[sub][i] = 0.f;
#pragma unroll
    for (int ks = 0; ks < DQK / 16; ++ks) {
      const bf16x8 kf = *(const bf16x8*)(Kt + (sub * 32 + r) * KP + ks * 32 + h * 16);
      s[sub] = MFMA32(kf, qf[ks], s[sub]);
    }
  }
  float tmax = -INFINITY;
#pragma unroll
  for (int sub = 0; sub < 2; ++sub)
#pragma unroll
    for (int i = 0; i < 16; ++i) {
      const float v = bias(sub * 32 + crow(i, h), s[sub][i]);
      s[sub][i] = v;
      tmax = fmaxf(tmax, v);
    }
  tmax = half_max(tmax);
  const float m_new = fmaxf(m, tmax);
  const float m_safe = (m_new == -INFINITY) ? 0.f : m_new;
  const float alpha = __builtin_amdgcn_exp2f(m - m_safe);
  float psum = 0.f;
#pragma unroll
  for (int sub = 0; sub < 2; ++sub)
#pragma unroll
    for (int i = 0; i < 16; ++i) {
      const float pv = __builtin_amdgcn_exp2f(s[sub][i] - m_safe);
      s[sub][i] = pv;
      psum += pv;
    }
  psum = half_sum(psum);
  lsum = lsum * alpha + psum;
  m = m_new;
  if (__builtin_amdgcn_ballot_w64(alpha != 1.f) != 0) {
#pragma unroll
    for (int mt = 0; mt < DV / 32; ++mt)
#pragma unroll
      for (int i = 0; i < 16; ++i) o[mt][i] *= alpha;
  }
  const int i16 = lane & 15, q4 = i16 >> 2, p4 = i16 & 3, blk = (lane >> 4) & 1;
#pragma unroll
  for (int kk = 0; kk < 4; ++kk) {
    const int sub = kk >> 1, s2 = kk & 1;
    u32x4 pu;
#pragma unroll
    for (int jj = 0; jj < 4; ++jj) pu[jj] = pack2(s[sub][8 * s2 + 2 * jj], s[sub][8 * s2 + 2 * jj + 1]);
    const bf16x8 pfv = __builtin_bit_cast(bf16x8, pu);
#pragma unroll
    for (int mt = 0; mt < DV / 32; ++mt) {
      const char* vb = Vt + (kk * 16 + 4 * h + q4) * VP + (mt * 32 + 16 * blk + 4 * p4) * 2;
      const s16x4 lo = __builtin_amdgcn_ds_read_tr16_b64_v4i16(LDSP(s16x4, vb));
      const s16x4 hi = __builtin_amdgcn_ds_read_tr16_b64_v4i16(LDSP(s16x4, vb + 8 * VP));
      const bf16x8 vf = __builtin_shufflevector(lo, hi, 0, 1, 2, 3, 4, 5, 6, 7);
      o[mt] = MFMA32(vf, pfv, o[mt]);
    }
  }
}

DI void a_attn_item(const Params& P, int item) {
  const u16* p = (const u16*)(P.ws + OFF_P);
  u16* Ao = (u16*)(P.ws + OFF_AO);
  float* Alse = (float*)(P.ws + OFF_ALSE);
  const int tid = otid(), lane = tid & 63, w = tid >> 6, r32 = lane & 31, h = lane >> 5;
  const int u = item * 8 + w;
  const int half = u & 1, nbr = (u >> 1) & 63, hi = u >> 7, slot = hi % 6, g = (hi / 6) % 3, b = hi / 18;
  const int dil = (g == 0) ? 1 : (g == 1 ? 4 : 16);
  const int L = SEQ / dil, res = nbr % dil, l0 = (nbr / dil) * 64;
  const float slope = exp2f(-8.f * (float)(slot + 1) / 6.f) * (float)dil * LOG2E;
  const int lq = l0 + half * 32 + r32;
  const size_t qrow = (size_t)b * SEQ + res + dil * lq;
  bf16x8 qf[4];
#pragma unroll
  for (int ks = 0; ks < 4; ++ks) qf[ks] = *(const bf16x8*)(p + qrow * INW + C_AQ + g * 384 + slot * 64 + ks * 16 + h * 8);
  char* Kw = shm + w * 18432;
  char* Vw = Kw + 9216;
  f32x16 o[2];
#pragma unroll
  for (int mt = 0; mt < 2; ++mt)
#pragma unroll
    for (int i = 0; i < 16; ++i) o[mt][i] = 0.f;
  float m = -INFINITY, lsum = 0.f;
  for (int kt = 0; kt < 3; ++kt) {
    const int lk0 = l0 - 64 + kt * 64;
    uint4 kv[8], vv[8];
#pragma unroll
    for (int i = 0; i < 8; ++i) {
      const int idx = lane + 64 * i, rr = idx >> 3, ch = idx & 7, lk = lk0 + rr;
      const bool valid = (lk >= 0) && (lk < L);
      const size_t krow = (size_t)b * SEQ + res + dil * (valid ? lk : 0);
      const u16* src = p + krow * INW + g * 384 + slot * 64 + ch * 8;
      kv[i] = valid ? *(const uint4*)(src + C_AK) : uint4{0, 0, 0, 0};
      vv[i] = valid ? *(const uint4*)(src + C_AV) : uint4{0, 0, 0, 0};
    }
    __builtin_amdgcn_wave_barrier();
#pragma unroll
    for (int i = 0; i < 8; ++i) {
      const int idx = lane + 64 * i, rr = idx >> 3, ch = idx & 7;
      *(uint4*)(Kw + rr * 144 + ch * 16) = kv[i];
      *(uint4*)(Vw + rr * 144 + ch * 16) = vv[i];
    }
    __builtin_amdgcn_wave_barrier();
    flash_tile<64, 64>(qf, Kw, 144, Vw, 144, o, m, lsum, [&](int key, float v) {
      const int lk = lk0 + key, rel = lk - lq, ar = rel < 0 ? -rel : rel;
      const bool ok = (ar <= 64) && (lk >= 0) && (lk < L);
      return ok ? v - slope * (float)ar : -INFINITY;
    });
    __builtin_amdgcn_wave_barrier();
  }
  const float inv = 1.f / lsum;
#pragma unroll
  for (int mt = 0; mt < 2; ++mt)
#pragma unroll
    for (int g4 = 0; g4 < 4; ++g4) {
      uint2 ov;
      ov.x = pack2(o[mt][4 * g4] * inv, o[mt][4 * g4 + 1] * inv);
      ov.y = pack2(o[mt][4 * g4 + 2] * inv, o[mt][4 * g4 + 3] * inv);
      *(uint2*)(Ao + ((size_t)g * NTOK + qrow) * 384 + slot * 64 + mt * 32 + 8 * g4 + 4 * h) = ov;
    }
  if (h == 0) Alse[((size_t)g * NTOK + qrow) * 6 + slot] = m + __log2f(lsum);
}

DI void a_combine_item(const Params& P, int item) {
  const u16* p = (const u16*)(P.ws + OFF_P);
  const u16* Ao = (const u16*)(P.ws + OFF_AO);
  const float* Alse = (const float*)(P.ws + OFF_ALSE);
  u16* Y = (u16*)(P.ws + OFF_Y);
  for (int idx = otid(); idx < 128 * 48; idx += 512) {
    const size_t tok = (size_t)item * 128 + idx / 48;
    const int sc = idx % 48, slot = sc >> 3, d0 = (sc & 7) * 8;
    const float l0 = Alse[(0 * (size_t)NTOK + tok) * 6 + slot], l1 = Alse[(1 * (size_t)NTOK + tok) * 6 + slot],
                l2 = Alse[(2 * (size_t)NTOK + tok) * 6 + slot];
    const float mx = fmaxf(l0, fmaxf(l1, l2));
    float w0 = exp2f(l0 - mx), w1 = exp2f(l1 - mx), w2 = exp2f(l2 - mx);
    const float ws_ = 1.f / (w0 + w1 + w2);
    w0 *= ws_; w1 *= ws_; w2 *= ws_;
    const uint4 a0 = *(const uint4*)(Ao + (0 * (size_t)NTOK + tok) * 384 + slot * 64 + d0);
    const uint4 a1 = *(const uint4*)(Ao + (1 * (size_t)NTOK + tok) * 384 + slot * 64 + d0);
    const uint4 a2 = *(const uint4*)(Ao + (2 * (size_t)NTOK + tok) * 384 + slot * 64 + d0);
    const uint4 gg = *(const uint4*)(p + tok * INW + C_AG + slot * 64 + d0);
    const unsigned* pa0 = (const unsigned*)&a0; const unsigned* pa1 = (const unsigned*)&a1; const unsigned* pa2 = (const unsigned*)&a2;
    const unsigned* pg = (const unsigned*)&gg;
    unsigned ov[4];
#pragma unroll
    for (int j = 0; j < 4; ++j) {
      const float lo = (w0 * bf2f(pa0[j] & 0xffff) + w1 * bf2f(pa1[j] & 0xffff) + w2 * bf2f(pa2[j] & 0xffff)) * bf2f(pg[j] & 0xffff);
      const float hi = (w0 * bf2f(pa0[j] >> 16) + w1 * bf2f(pa1[j] >> 16) + w2 * bf2f(pa2[j] >> 16)) * bf2f(pg[j] >> 16);
      ov[j] = pack2(lo, hi);
    }
    *(uint4*)(Y + tok * YW + Y_A + slot * 64 + d0) = uint4{ov[0], ov[1], ov[2], ov[3]};
  }
}

DI void b_item(const Params& P, int l, int item, int mode) {
  const u16* p = (const u16*)(P.ws + OFF_P);
  float* sA = (float*)(P.ws + OFF_SA);
  float* sU = (float*)(P.ws + OFF_SU);
  u16* Y = (u16*)(P.ws + OFF_Y);
  const u16* lruT = (const u16*)(P.ws + OFF_LRUT);
  const int tid = otid(), lane = tid & 63, w = tid >> 6;
  const int n = item % 6, ck = (item / 6) & 63, b = item / 384;
  const int t0 = ck * 64;
  float(*xs)[64] = (float(*)[64])(shm);
  float(*xcf)[64] = (float(*)[64])(shm + 17408);
  u16(*xcb)[72] = (u16(*)[72])(shm + 33792);
  float(*gt)[64][64] = (float(*)[64][64])(shm + 43008);
  float(*hs)[64][64] = (float(*)[64][64])(shm + 108544);
  for (int idx = tid; idx < 67 * 64; idx += 512) {
    const int rr = idx >> 6, c = idx & 63, t = t0 - 1 + rr;
    xs[rr][c] = (t >= 0 && t < SEQ) ? bf2f(p[((size_t)b * SEQ + t) * INW + C_BX + n * 64 + c]) : 0.f;
  }
  __syncthreads();
  for (int idx = tid; idx < 64 * 64; idx += 512) {
    const int t = idx >> 6, c = idx & 63, ch = n * 64 + c;
    const float* cw = P.conv_w + (size_t)l * 4 * 384 + ch;
    const float v = P.conv_b[l * 384 + ch] + cw[0] * xs[t][c] + cw[384] * xs[t + 1][c] + cw[768] * xs[t + 2][c] + cw[1152] * xs[t + 3][c];
    xcf[t][c] = v;
    xcb[t][c] = f2bf(v);
  }
  __syncthreads();
  {
    const int mat = w & 3, dir = mat >> 1, ri = mat & 1, th = w >> 2, r32 = lane & 31, h = lane >> 5;
    f32x16 acc[2];
#pragma unroll
    for (int nt2 = 0; nt2 < 2; ++nt2)
#pragma unroll
      for (int i = 0; i < 16; ++i) acc[nt2][i] = 0.f;
    const u16* wb = lruT + ((size_t)(((l * 2 + dir) * 2 + ri) * 6 + n) * 64) * 64;
#pragma unroll
    for (int ks = 0; ks < 4; ++ks) {
      const bf16x8 a = *(const bf16x8*)(&xcb[th * 32 + r32][ks * 16 + h * 8]);
#pragma unroll
      for (int nt2 = 0; nt2 < 2; ++nt2) {
        const bf16x8 bb = *(const bf16x8*)(wb + (size_t)(nt2 * 32 + r32) * 64 + ks * 16 + h * 8);
        acc[nt2] = MFMA32(a, bb, acc[nt2]);
      }
    }
    const float* bias = (ri ? P.lru_bi : P.lru_br) + (l * 2 + dir) * 384 + n * 64;
#pragma unroll
    for (int nt2 = 0; nt2 < 2; ++nt2) {
      const int d = nt2 * 32 + r32;
      const float bv = bias[d];
#pragma unroll
      for (int i = 0; i < 16; ++i) gt[mat][th * 32 + crow(i, h)][d] = sigmoidf_(acc[nt2][i] + bv);
    }
  }
  __syncthreads();
  for (int idx = tid; idx < 2 * 64 * 64; idx += 512) {
    const int dir = idx >> 12, t = (idx >> 6) & 63, d = idx & 63, ch = n * 64 + d;
    const float rg = gt[dir * 2][t][d], ig = gt[dir * 2 + 1][t][d];
    const float lam = P.lru_lambda[(l * 2 + dir) * 384 + ch];
    const float sp = log1pf(__expf(-lam));
    const float log_a = -8.f * rg * sp;
    const float a = __expf(log_a);
    const float u = sqrtf(fmaxf(-expm1f(2.f * log_a), 0.f)) * (ig * xcf[t][d]);
    gt[dir * 2][t][d] = a;
    gt[dir * 2 + 1][t][d] = u;
  }
  __syncthreads();
  if (tid < 128) {
    const int dir = tid >> 6, d = tid & 63, ch = n * 64 + d;
    float hcar = 0.f, pp = 1.f;
    if (mode == 1) {
      if (dir == 0) {
        for (int k = 0; k < ck; ++k) {
          const size_t si = ((size_t)(b * 64 + k) * 2 + 0) * 384 + ch;
          hcar = sA[si] * hcar + sU[si];
        }
      } else {
        for (int k = 63; k > ck; --k) {
          const size_t si = ((size_t)(b * 64 + k) * 2 + 1) * 384 + ch;
          hcar = sA[si] * hcar + sU[si];
        }
      }
    }
    if (dir == 0) {
      for (int t = 0; t < 64; ++t) {
        const float a = gt[0][t][d];
        hcar = a * hcar + gt[1][t][d];
        pp *= a;
        hs[0][t][d] = hcar;
      }
    } else {
      for (int t = 63; t >= 0; --t) {
        const float a = gt[2][t][d];
        hcar = a * hcar + gt[3][t][d];
        pp *= a;
        hs[1][t][d] = hcar;
      }
    }
    if (mode == 0) {
      const size_t si = ((size_t)(b * 64 + ck) * 2 + dir) * 384 + ch;
      sA[si] = pp;
      sU[si] = hcar;
    }
  }
  if (mode == 1) {
    __syncthreads();
    for (int idx = tid; idx < 64 * 64; idx += 512) {
      const int t = idx >> 6, c = idx & 63, ch = n * 64 + c;
      const size_t tok = (size_t)b * SEQ + t0 + t;
      const float v = (hs[0][t][c] + hs[1][t][c]) * bf2f(p[tok * INW + C_BG + ch]);
      Y[tok * YW + Y_B + ch] = f2bf(v);
    }
  }
}

template <bool isq>
DI void dprep_item(const Params& P, int l, int item) {
  const u16* p = (const u16*)(P.ws + OFF_P);
  u16* Dq = (u16*)(P.ws + OFF_DQ);
  u16* Dk = (u16*)(P.ws + OFF_DK);
  u16* Dv = (u16*)(P.ws + OFF_DV);
  const float* rope = (const float*)(P.ws + OFF_ROPE);
  const int tid = otid(), wid = tid >> 6, lane = tid & 63, wr = wid >> 2, wc = wid & 3, fr = lane & 15, fq = lane >> 4;
  const int it = item, pm = it / 3, pn = it % 3;
  constexpr int K = isq ? 256 : 128;
  const u16* A = p + (size_t)pm * 256 * INW + (isq ? C_DCQ : C_DCKV);
  const u16* Bt = (isq ? (const u16*)(P.ws + OFF_WUQT) : (const u16*)(P.ws + OFF_WUKVT)) + (size_t)l * 768 * K + (size_t)pn * 256 * K;
  float* rsq = (float*)(shm + 131072);
  {
    const int row = tid >> 1, hf = tid & 1;
    const u16* src = A + (size_t)row * INW + hf * (K / 2);
    float ss = 0.f;
    for (int c = 0; c < K / 2; c += 8) {
      const uint4 v = *(const uint4*)(src + c);
      const unsigned* pv = (const unsigned*)&v;
#pragma unroll
      for (int j = 0; j < 4; ++j) {
        const float a = bf2f(pv[j] & 0xffff), bq = bf2f(pv[j] >> 16);
        ss += a * a + bq * bq;
      }
    }
    ss += __shfl_xor(ss, 1);
    if (!hf) rsq[row] = rsqrtf(ss / (float)K + EPS);
  }
  __syncthreads();
  f32x4 acc[8][4];
#pragma unroll
  for (int m = 0; m < 8; ++m)
#pragma unroll
    for (int n = 0; n < 4; ++n) acc[m][n] = f32x4{0.f, 0.f, 0.f, 0.f};
  gemm_tile<4>(A, INW, Bt, K, K / 64, acc);
  if (isq) {
#pragma unroll
    for (int n = 0; n < 4; ++n) {
      const int col0 = pn * 256 + wc * 64 + n * 16;
      if (col0 >= 576) continue;
      const int hh = col0 / 96, e0 = col0 % 96;
      if (e0 == 80) continue;
#pragma unroll
      for (int m = 0; m < 8; ++m) {
        const int rl = wr * 128 + m * 16 + fr;
        const size_t row = (size_t)pm * 256 + rl;
        const float rs = rsq[rl];
        const float v0 = acc[m][n][0] * rs, v1 = acc[m][n][1] * rs, v2 = acc[m][n][2] * rs, v3 = acc[m][n][3] * rs;
        if (e0 == 64) {
          const float x0 = acc[m][(n + 1) & 3][0] * rs, x1 = acc[m][(n + 1) & 3][1] * rs, x2 = acc[m][(n + 1) & 3][2] * rs,
                      x3 = acc[m][(n + 1) & 3][3] * rs;
          const int pos = (int)(row & (SEQ - 1));
          const float4 ca = *(const float4*)(rope + (pos * 16 + fq * 4) * 2);
          const float4 cb = *(const float4*)(rope + (pos * 16 + fq * 4) * 2 + 4);
          *(uint2*)(Dq + row * 576 + hh * 96 + 64 + fq * 4) =
              uint2{pack2(v0 * ca.x - x0 * ca.y, v1 * ca.z - x1 * ca.w), pack2(v2 * cb.x - x2 * cb.y, v3 * cb.z - x3 * cb.w)};
          *(uint2*)(Dq + row * 576 + hh * 96 + 80 + fq * 4) =
              uint2{pack2(v0 * ca.y + x0 * ca.x, v1 * ca.w + x1 * ca.z), pack2(v2 * cb.y + x2 * cb.x, v3 * cb.w + x3 * cb.z)};
        } else {
          *(uint2*)(Dq + row * 576 + hh * 96 + e0 + fq * 4) = uint2{pack2(v0, v1), pack2(v2, v3)};
        }
      }
    }
  } else {
#pragma unroll
    for (int n = 0; n < 4; ++n) {
      const int col0 = pn * 256 + wc * 64 + n * 16;
      const int hh = col0 / 128, e0 = col0 % 128;
#pragma unroll
      for (int m = 0; m < 8; ++m) {
        const int rl = wr * 128 + m * 16 + fr;
        const size_t row = (size_t)pm * 256 + rl;
        const float rs = rsq[rl];
        const uint2 ov = uint2{pack2(acc[m][n][0] * rs, acc[m][n][1] * rs), pack2(acc[m][n][2] * rs, acc[m][n][3] * rs)};
        if (e0 < 64) *(uint2*)(Dk + row * 576 + hh * 96 + e0 + fq * 4) = ov;
        else *(uint2*)(Dv + row * 384 + hh * 64 + (e0 - 64) + fq * 4) = ov;
      }
    }
    if (pn == 0) {
      for (int idx = tid; idx < 256 * 16; idx += 512) {
        const int rl = idx >> 4, i = idx & 15;
        const size_t row = (size_t)pm * 256 + rl;
        const float x1 = bf2f(p[row * INW + C_DKR + i]), x2 = bf2f(p[row * INW + C_DKR + 16 + i]);
        const int pos = (int)(row & (SEQ - 1));
        const float c = rope[(pos * 16 + i) * 2], s = rope[(pos * 16 + i) * 2 + 1];
        const u16 o1 = f2bf(x1 * c - x2 * s), o2 = f2bf(x1 * s + x2 * c);
#pragma unroll
        for (int hh = 0; hh < 6; ++hh) {
          Dk[row * 576 + hh * 96 + 64 + i] = o1;
          Dk[row * 576 + hh * 96 + 80 + i] = o2;
        }
      }
    }
  }
}

DI void c_attn_item(const Params& P, int l, int item) {
  const u16* p = (const u16*)(P.ws + OFF_P);
  u16* Y = (u16*)(P.ws + OFF_Y);
  const int tid = otid(), lane = tid & 63, w = tid >> 6, r32 = lane & 31, h = lane >> 5;
  const int qb = item & 31, hh = (item >> 5) & 3, b = item >> 7;
  const int cmap = w >> 2, q0 = qb * 128 + (w & 3) * 32;
  const size_t qrow = (size_t)b * SEQ + q0 + r32;
  const float slope = exp2f(-2.f * (float)(hh + 1)) * LOG2E;
  bf16x8 qf[4];
#pragma unroll
  for (int ks = 0; ks < 4; ++ks) qf[ks] = *(const bf16x8*)(p + qrow * INW + C_CQ + hh * 128 + cmap * 64 + ks * 16 + h * 8);
  constexpr int KP = 272, STG = 2 * 64 * KP;
  f32x16 o[4];
#pragma unroll
  for (int mt = 0; mt < 4; ++mt)
#pragma unroll
    for (int i = 0; i < 16; ++i) o[mt][i] = 0.f;
  float m = -INFINITY, lsum = 0.f;
  const u16* kvbase = p + (size_t)b * SEQ * INW + hh * 128;
  uint4 st0, st1, st2, st3;
  const int crr = tid >> 4, cch = tid & 15;
#define gload(kt)                                                                                       \
  do {                                                                                                  \
    const u16* g0 = kvbase + (size_t)((kt) * 64 + crr) * INW + cch * 8;                                 \
    st0 = *(const uint4*)(g0 + C_CK);                                                                   \
    st1 = *(const uint4*)(g0 + (size_t)32 * INW + C_CK);                                                \
    st2 = *(const uint4*)(g0 + C_CV);                                                                   \
    st3 = *(const uint4*)(g0 + (size_t)32 * INW + C_CV);                                                \
  } while (0)
#define lstore(buf)                                                                                     \
  do {                                                                                                  \
    char* l0 = shm + (buf) * STG + crr * KP + cch * 16;                                                 \
    *(uint4*)(l0) = st0;                                                                                \
    *(uint4*)(l0 + 32 * KP) = st1;                                                                      \
    *(uint4*)(l0 + 64 * KP) = st2;                                                                      \
    *(uint4*)(l0 + 96 * KP) = st3;                                                                      \
  } while (0)
  gload(0);
  lstore(0);
  __syncthreads();
  const float qpos = (float)(q0 + r32);
  for (int kt = 0; kt < 64; ++kt) {
    const int cur = kt & 1;
    if (kt + 1 < 64) gload(kt + 1);
    const float kbase = (float)(kt * 64);
    flash_tile<64, 128>(qf, shm + cur * STG + cmap * 128, KP, shm + cur * STG + 64 * KP, KP, o, m, lsum,
                        [&](int key, float v) { return v - slope * fabsf(qpos - (kbase + (float)key)); });
    if (kt + 1 < 64) lstore(cur ^ 1);
    __syncthreads();
  }
#undef gload
#undef lstore
  float* ex = (float*)(shm + 2 * STG);
  const float inv = 1.f / lsum;
  if (cmap == 1) {
#pragma unroll
    for (int mt = 0; mt < 4; ++mt)
#pragma unroll
      for (int i = 0; i < 16; ++i) ex[((w & 3) * 64 + mt * 16 + i) * 64 + lane] = o[mt][i] * inv;
  }
  __syncthreads();
  if (cmap == 0) {
    float d1 = 0.f, d2 = 0.f;
    {
      const float a1 = P.lq1[l * 64 + lane] * P.lk1[l * 64 + lane], a2 = P.lq2[l * 64 + lane] * P.lk2[l * 64 + lane];
      d1 = wave_sum(a1);
      d2 = wave_sum(a2);
    }
    const float lam_init = 0.8f - 0.6f * expf(-0.3f * (float)l);
    const float lam = expf(d1) - expf(d2) + lam_init;
    float ss = 0.f;
#pragma unroll
    for (int mt = 0; mt < 4; ++mt)
#pragma unroll
      for (int i = 0; i < 16; ++i) {
        const float dv = o[mt][i] * inv - lam * ex[((w & 3) * 64 + mt * 16 + i) * 64 + lane];
        o[mt][i] = dv;
        ss += dv * dv;
      }
    ss += __shfl_xor(ss, 32);
    const float rs = rsqrtf(ss * (1.f / 128.f) + EPS) * (1.f - lam_init);
#pragma unroll
    for (int mt = 0; mt < 4; ++mt)
#pragma unroll
      for (int g4 = 0; g4 < 4; ++g4) {
        const int dv0 = mt * 32 + 8 * g4 + 4 * h;
        const float4 sg = *(const float4*)(P.subln + l * 128 + dv0);
        const uint2 gg = *(const uint2*)(p + qrow * INW + C_CG + hh * 128 + dv0);
        uint2 ov;
        ov.x = pack2(o[mt][4 * g4] * rs * sg.x * bf2f(gg.x & 0xffff), o[mt][4 * g4 + 1] * rs * sg.y * bf2f(gg.x >> 16));
        ov.y = pack2(o[mt][4 * g4 + 2] * rs * sg.z * bf2f(gg.y & 0xffff), o[mt][4 * g4 + 3] * rs * sg.w * bf2f(gg.y >> 16));
        *(uint2*)(Y + qrow * YW + Y_C + hh * 128 + dv0) = ov;
      }
  }
}

DI void d_attn_item(const Params& P, int item) {
  const u16* p = (const u16*)(P.ws + OFF_P);
  const u16* Dq = (const u16*)(P.ws + OFF_DQ);
  const u16* Dk = (const u16*)(P.ws + OFF_DK);
  const u16* Dv = (const u16*)(P.ws + OFF_DV);
  u16* Y = (u16*)(P.ws + OFF_Y);
  const int tid = otid(), lane = tid & 63, w = tid >> 6, r32 = lane & 31, h = lane >> 5;
  const int qb = item & 15, hh = (item >> 4) % 6, b = (item >> 4) / 6;
  const size_t qrow = (size_t)b * SEQ + qb * 256 + w * 32 + r32;
  bf16x8 qf[6];
#pragma unroll
  for (int ks = 0; ks < 6; ++ks) qf[ks] = *(const bf16x8*)(Dq + qrow * 576 + hh * 96 + ks * 16 + h * 8);
  constexpr int KP = 208, VP = 144, STG = 64 * KP + 64 * VP;
  f32x16 o[2];
#pragma unroll
  for (int mt = 0; mt < 2; ++mt)
#pragma unroll
    for (int i = 0; i < 16; ++i) o[mt][i] = 0.f;
  float m = -INFINITY, lsum = 0.f;
  const u16* kb = Dk + (size_t)b * SEQ * 576 + hh * 96;
  const u16* vb = Dv + (size_t)b * SEQ * 384 + hh * 64;
  uint4 st0, st1, st2 = uint4{0, 0, 0, 0};
  const int r0 = tid / 12, c0 = tid % 12;
  const int i1 = tid + 512, i2 = tid + 1024;
  const bool k1 = i1 < 768, has2 = i2 < 1280;
  const int r1 = k1 ? i1 / 12 : (i1 - 768) >> 3, c1 = k1 ? i1 % 12 : (i1 - 768) & 7;
  const int r2 = (i2 - 768) >> 3, c2 = (i2 - 768) & 7;
  const u16* gp0 = kb + (size_t)r0 * 576 + c0 * 8;
  const u16* gp1 = k1 ? kb + (size_t)r1 * 576 + c1 * 8 : vb + (size_t)r1 * 384 + c1 * 8;
  const size_t gs1 = k1 ? 64 * 576 : 64 * 384;
  const u16* gp2 = vb + (size_t)r2 * 384 + c2 * 8;
  const int lo0 = r0 * KP + c0 * 16, lo1 = k1 ? r1 * KP + c1 * 16 : 64 * KP + r1 * VP + c1 * 16, lo2 = 64 * KP + r2 * VP + c2 * 16;
#define gload(kt)                                                     \
  do {                                                                \
    st0 = *(const uint4*)(gp0 + (size_t)(kt) * 64 * 576);             \
    st1 = *(const uint4*)(gp1 + (size_t)(kt) * gs1);                  \
    if (has2) st2 = *(const uint4*)(gp2 + (size_t)(kt) * 64 * 384);   \
  } while (0)
#define lstore(buf)                                                   \
  do {                                                                \
    *(uint4*)(shm + (buf) * STG + lo0) = st0;                         \
    *(uint4*)(shm + (buf) * STG + lo1) = st1;                         \
    if (has2) *(uint4*)(shm + (buf) * STG + lo2) = st2;               \
  } while (0)
  gload(0);
  lstore(0);
  __syncthreads();
  for (int kt = 0; kt < 64; ++kt) {
    const int cur = kt & 1;
    if (kt + 1 < 64) gload(kt + 1);
    flash_tile<96, 64>(qf, shm + cur * STG, KP, shm + cur * STG + 64 * KP, VP, o, m, lsum, [&](int, float v) { return v; });
    if (kt + 1 < 64) lstore(cur ^ 1);
    __syncthreads();
  }
#undef gload
#undef lstore
  const float inv = 1.f / lsum;
#pragma unroll
  for (int mt = 0; mt < 2; ++mt)
#pragma unroll
    for (int g4 = 0; g4 < 4; ++g4) {
      const int dv0 = mt * 32 + 8 * g4 + 4 * h;
      const uint2 gg = *(const uint2*)(p + qrow * INW + C_DG + hh * 64 + dv0);
      uint2 ov;
      ov.x = pack2(o[mt][4 * g4] * inv * bf2f(gg.x & 0xffff), o[mt][4 * g4 + 1] * inv * bf2f(gg.x >> 16));
      ov.y = pack2(o[mt][4 * g4 + 2] * inv * bf2f(gg.y & 0xffff), o[mt][4 * g4 + 3] * inv * bf2f(gg.y >> 16));
      *(uint2*)(Y + qrow * YW + Y_D + hh * 64 + dv0) = ov;
    }
}

DI void phase_prep(const Params& P, int l, int coff = 0) {
  unsigned* ctr = (unsigned*)(P.ws + OFF_CTR) + (l * 2 + 0) + coff;
  constexpr int N_D = 384, N_B = 1536, N_A = 1152;
  for (;;) {
    const int item = next_item(ctr);
    if (item >= N_D + N_B + N_A) break;
    if (item < 192) { if (IM & 1) dprep_item<true>(P, l, item); }
    else if (item < N_D) { if (IM & 1) dprep_item<false>(P, l, item - 192); }
    else if (item < N_D + N_B) { if (IM & 2) b_item(P, l, item - N_D, 0); }
    else { if (IM & 4) a_attn_item(P, item - N_D - N_B); }
  }
}
DI void phase_attn(const Params& P, int l, int coff = 0) {
  unsigned* ctr = (unsigned*)(P.ws + OFF_CTR) + (l * 2 + 1) + coff;
  constexpr int N_C = 512, N_D = 384, N_B = 1536, N_A = 128;
  for (;;) {
    const int item = next_item(ctr);
    if (item >= N_C + N_D + N_B + N_A) break;
    if (item < N_C) { if (IM & 8) c_attn_item(P, l, item); }
    else if (item < N_C + N_D) { if (IM & 16) d_attn_item(P, item - N_C); }
    else if (item < N_C + N_D + N_B) { if (IM & 32) b_item(P, l, item - N_C - N_D, 1); }
    else { if (IM & 64) a_combine_item(P, item - N_C - N_D - N_B); }
  }
}

DI void phase_merge(const Params& P, int l) {
  const u16* p = (const u16*)(P.ws + OFF_P);
  const u16* Y = (const u16*)(P.ws + OFF_Y);
  const u16* wT = (const u16*)(P.ws + OFF_WBRT) + (size_t)l * 1024 * YW;
  u16* mrg = (u16*)(P.ws + OFF_HB);
  const int tid = otid(), wid = tid >> 6, lane = tid & 63, wr = wid >> 2, wc = wid & 3, fr = lane & 15, fq = lane >> 4;
  for (int t = blockIdx.x; t < 64 * 8; t += gridDim.x) {
    const int pn = t & 7, pm = t >> 3;
    f32x4 mg[8][2];
#pragma unroll
    for (int m = 0; m < 8; ++m)
#pragma unroll
      for (int n = 0; n < 2; ++n) mg[m][n] = f32x4{0.f, 0.f, 0.f, 0.f};
#pragma unroll 1
    for (int br = 0; br < 4; ++br) {
      const int koff = (br == 0) ? Y_A : (br == 1 ? Y_B : (br == 2 ? Y_C : Y_D));
      const int nk = (br == 2) ? 8 : 6;
      f32x4 acc[8][2];
#pragma unroll
      for (int m = 0; m < 8; ++m)
#pragma unroll
        for (int n = 0; n < 2; ++n) acc[m][n] = f32x4{0.f, 0.f, 0.f, 0.f};
      gemm_tile<2>(Y + (size_t)pm * 256 * YW + koff, YW, wT + (size_t)pn * 128 * YW + koff, YW, nk, acc);
#pragma unroll
      for (int m = 0; m < 8; ++m)
#pragma unroll
        for (int n = 0; n < 2; ++n) {
          const size_t row = (size_t)pm * 256 + wr * 128 + m * 16 + fr;
          const int col = pn * 128 + wc * 32 + n * 16 + fq * 4;
          const uint2 g = *(const uint2*)(p + row * INW + C_GATE + br * 1024 + col);
          mg[m][n][0] += bf2f(g.x & 0xffff) * acc[m][n][0];
          mg[m][n][1] += bf2f(g.x >> 16) * acc[m][n][1];
          mg[m][n][2] += bf2f(g.y & 0xffff) * acc[m][n][2];
          mg[m][n][3] += bf2f(g.y >> 16) * acc[m][n][3];
        }
    }
#pragma unroll
    for (int m = 0; m < 8; ++m)
#pragma unroll
      for (int n = 0; n < 2; ++n) {
        const size_t row = (size_t)pm * 256 + wr * 128 + m * 16 + fr;
        const int col = pn * 128 + wc * 32 + n * 16 + fq * 4;
        *(uint2*)(mrg + row * DM + col) = uint2{pack2(mg[m][n][0], mg[m][n][1]), pack2(mg[m][n][2], mg[m][n][3])};
      }
  }
}

DI void phase_outproj(const Params& P, int l) {
  const u16* mrg = (const u16*)(P.ws + OFF_HB);
  const u16* wT = (const u16*)(P.ws + OFF_WOUTT) + (size_t)l * DM * DM;
  float* oraw = (float*)(P.ws + OFF_P);
  const int tid = otid(), wid = tid >> 6, lane = tid & 63, wr = wid >> 2, wc = wid & 3, fr = lane & 15, fq = lane >> 4;
  for (int t = blockIdx.x; t < 64 * 4; t += gridDim.x) {
    const int pn = t & 3, pm = t >> 2;
    f32x4 acc[8][4];
#pragma unroll
    for (int m = 0; m < 8; ++m)
#pragma unroll
      for (int n = 0; n < 4; ++n) acc[m][n] = f32x4{0.f, 0.f, 0.f, 0.f};
    gemm_tile<4>(mrg + (size_t)pm * 256 * DM, DM, wT + (size_t)pn * 256 * DM, DM, DM / 64, acc);
#pragma unroll
    for (int m = 0; m < 8; ++m)
#pragma unroll
      for (int n = 0; n < 4; ++n)
      {
          const size_t row = (size_t)pm * 256 + wr * 128 + m * 16 + fr;
          const int col = pn * 256 + wc * 64 + n * 16 + fq * 4;
          *(float4*)(oraw + row * DM + col) = float4{acc[m][n][0], acc[m][n][1], acc[m][n][2], acc[m][n][3]};
        }
  }
}

__global__ void __launch_bounds__(512, 2) mixer_megakernel(Params P) {
  cg::grid_group grid = cg::this_grid();
  for (int ph = P.phase_lo; ph < P.phase_hi; ++ph) {
    if (ph > P.phase_lo) grid.sync();
#ifndef ONLY
#define ONLY -1
#endif
    if (ph == 0) { if (ONLY<0||ONLY==0) phase_prologue(P); continue; }
    if (ph == NPHASE - 1) { if (ONLY<0||ONLY==1) phase_norm(P, DEPTH); continue; }
    const int l = (ph - 1) / 6, s = (ph - 1) % 6;
#ifdef REP
    if (s == REP) {
      switch (s) {
        case 1: phase_inproj(P, l); break;
        case 2: phase_prep(P, l, 16); break;
        case 3: phase_attn(P, l, 16); break;
        case 4: phase_merge(P, l); break;
        case 5: phase_outproj(P, l); break;
      }
      grid.sync();
    }
#endif
    switch (s) {
      case 0: if (ONLY<0||ONLY==1) phase_norm(P, l); break;
      case 1: if (ONLY<0||ONLY==2) phase_inproj(P, l); break;
      case 2: if (ONLY<0||ONLY==3) phase_prep(P, l); break;
      case 3: if (ONLY<0||ONLY==4) phase_attn(P, l); break;
      case 4: if (ONLY<0||ONLY==5) phase_merge(P, l); break;
      default: if (ONLY<0||ONLY==6) phase_outproj(P, l); break;
    }
  }
}

extern "C" void kernel_launch(void* const* d_in, const int* in_sizes, int n_in, void* d_out, int out_size, void* d_ws,
                              size_t ws_size, hipStream_t stream) {
  (void)in_sizes; (void)n_in; (void)out_size;
  if (ws_size < WS_NEED) { fprintf(stderr, "workspace too small: %zu < %zu\n", ws_size, WS_NEED); return; }
  Params P{};
  const float** f = (const float**)&P;
  for (int i = 0; i < 26; ++i) f[i] = (const float*)d_in[i];
  P.out = (float*)d_out;
  P.ws = (char*)d_ws;
  for (int i = 0; i < 16; ++i) P.inv[i] = std::pow(10000.0, -(double)i / 16.0);
  hipMemsetAsync(d_ws, 0, 4096, stream);
#if ONE_LAUNCH
  static int grid_blocks = 0;
  if (!grid_blocks) {
    int dev = 0, cus = 0, per_cu = 0;
    hipGetDevice(&dev);
    hipDeviceGetAttribute(&cus, hipDeviceAttributeMultiprocessorCount, dev);
    hipOccupancyMaxActiveBlocksPerMultiprocessor(&per_cu, mixer_megakernel, 512, 0);
    if (per_cu < 1) per_cu = 1;
    grid_blocks = cus * per_cu;
  }
  P.phase_lo = 0;
  P.phase_hi = NPHASE;
  void* args[] = {&P};
  hipError_t e = hipLaunchCooperativeKernel((void*)mixer_megakernel, dim3(grid_blocks), dim3(512), args, 0, stream);
  if (e != hipSuccess) fprintf(stderr, "cooperative launch failed: %s (grid %d)\n", hipGetErrorString(e), grid_blocks);
#else
  for (int ph = 0; ph < NPHASE; ++ph) {
    P.phase_lo = ph;
    P.phase_hi = ph + 1;
    hipLaunchKernelGGL(mixer_megakernel, dim3(256), dim3(512), 0, stream, P);
  }
#endif
}
```

```cpp
#include <hip/hip_runtime.h>
#include <hip/hip_cooperative_groups.h>
#include <cstdio>
#include <cmath>
namespace cg = cooperative_groups;

#ifndef IM
#define IM 127
#endif
#ifndef REPIM
#define REPIM 127
#endif
#ifndef ONE_LAUNCH
#define ONE_LAUNCH 1
#endif

typedef unsigned short u16;
typedef short bf16x8 __attribute__((ext_vector_type(8)));
typedef short s16x4 __attribute__((ext_vector_type(4)));
typedef float f32x4 __attribute__((ext_vector_type(4)));
typedef float f32x16 __attribute__((ext_vector_type(16)));
typedef unsigned u32x4 __attribute__((ext_vector_type(4)));
#define DI __device__ __forceinline__
#define LDSP(T, p) ((__attribute__((address_space(3))) T*)(p))

constexpr int NTOK = 16384, SEQ = 4096, DM = 1024, INW = 11552, DEPTH = 4;
constexpr int C_AQ = 0, C_AK = 1152, C_AV = 2304, C_AG = 3456, C_BX = 3840, C_BG = 4224, C_CQ = 4608, C_CK = 5120,
              C_CV = 5632, C_CG = 6144, C_DCQ = 6656, C_DCKV = 6912, C_DKR = 7040, C_DG = 7072, C_GATE = 7456;
constexpr int YW = 1664, Y_A = 0, Y_B = 384, Y_C = 768, Y_D = 1280;
constexpr float EPS = 1e-6f;
constexpr float LOG2E = 1.4426950408889634f, QSC = 0.125f * 1.4426950408889634f;
constexpr int NPHASE = 2 + 6 * DEPTH;

constexpr size_t OFF_CTR = 0;
constexpr size_t OFF_WINT = 4096;
constexpr size_t SZ_WINT = (size_t)DEPTH * 11776 * 1024 * 2;
constexpr size_t OFF_WUQT = OFF_WINT + SZ_WINT;
constexpr size_t SZ_WUQT = (size_t)DEPTH * 768 * 256 * 2;
constexpr size_t OFF_WUKVT = OFF_WUQT + SZ_WUQT;
constexpr size_t SZ_WUKVT = (size_t)DEPTH * 768 * 128 * 2;
constexpr size_t OFF_WBRT = OFF_WUKVT + SZ_WUKVT;
constexpr size_t SZ_WBRT = (size_t)DEPTH * 1024 * YW * 2;
constexpr size_t OFF_WOUTT = OFF_WBRT + SZ_WBRT;
constexpr size_t SZ_WOUTT = (size_t)DEPTH * 1024 * 1024 * 2;
constexpr size_t OFF_LRUT = OFF_WOUTT + SZ_WOUTT;
constexpr size_t SZ_LRUT = (size_t)DEPTH * 2 * 2 * 6 * 64 * 64 * 2;
constexpr size_t OFF_ROPE = OFF_LRUT + SZ_LRUT;
constexpr size_t SZ_ROPE = (size_t)SEQ * 16 * 2 * 4;
constexpr size_t OFF_HB = OFF_ROPE + SZ_ROPE;
constexpr size_t SZ_HB = (size_t)NTOK * DM * 2;
constexpr size_t OFF_P = OFF_HB + SZ_HB;
constexpr size_t SZ_P = (size_t)NTOK * INW * 2;
constexpr size_t OFF_DQ = OFF_P + SZ_P;
constexpr size_t SZ_DQ = (size_t)NTOK * 576 * 2;
constexpr size_t OFF_DK = OFF_DQ + SZ_DQ;
constexpr size_t OFF_DV = OFF_DK + SZ_DQ;
constexpr size_t SZ_DV = (size_t)NTOK * 384 * 2;
constexpr size_t OFF_AO = OFF_DV + SZ_DV;
constexpr size_t SZ_AO = (size_t)3 * NTOK * 384 * 2;
constexpr size_t OFF_ALSE = OFF_AO + SZ_AO;
constexpr size_t SZ_ALSE = (size_t)3 * NTOK * 6 * 4;
constexpr size_t OFF_SA = OFF_ALSE + SZ_ALSE;
constexpr size_t SZ_SA = (size_t)4 * 64 * 2 * 384 * 4;
constexpr size_t OFF_SU = OFF_SA + SZ_SA;
constexpr size_t OFF_Y = OFF_SU + SZ_SA;
constexpr size_t SZ_Y = (size_t)NTOK * YW * 2;
constexpr size_t WS_NEED = OFF_Y + SZ_Y;

struct Params {
  const float *x, *norm_pre, *norm_post, *w_in, *conv_w, *conv_b, *lru_wr, *lru_br, *lru_wi, *lru_bi, *lru_lambda,
      *lq1, *lk1, *lq2, *lk2, *subln, *qnorm, *kvnorm, *w_uq, *w_ukv, *w_br_a, *w_br_b, *w_br_c, *w_br_d, *b_gate, *w_out;
  float* out;
  char* ws;
  double inv[16];
  int phase_lo, phase_hi;
};

__shared__ __attribute__((aligned(1024))) char shm[147456];

DI int otid() { int t = threadIdx.x; asm volatile("" : "+v"(t)); return t; }
DI u16 f2bf(float x) { __bf16 b = (__bf16)x; return __builtin_bit_cast(u16, b); }
DI float bf2f(u16 b) { return __uint_as_float(((unsigned)b) << 16); }
typedef __bf16 bf16x2_t __attribute__((ext_vector_type(2)));
typedef float f32x2_t __attribute__((ext_vector_type(2)));
DI unsigned pack2(float a, float b) { f32x2_t f = {a, b}; bf16x2_t r = __builtin_convertvector(f, bf16x2_t); return __builtin_bit_cast(unsigned, r); }
DI float sigmoidf_(float v) { return 1.f / (1.f + __expf(-v)); }
DI float siluf_(float v) { return v / (1.f + __expf(-v)); }
#define MFMA32(a, b, c) __builtin_amdgcn_mfma_f32_32x32x16_bf16((a), (b), (c), 0, 0, 0)
#define MFMA16(a, b, c) __builtin_amdgcn_mfma_f32_16x16x32_bf16((a), (b), (c), 0, 0, 0)
DI int crow(int reg, int h) { return (reg & 3) + 8 * (reg >> 2) + 4 * h; }

DI int next_item(unsigned* ctr) {
  int* s = (int*)(shm + 147456 - 16);
  __syncthreads();
  if (threadIdx.x == 0) *s = (int)atomicAdd(ctr, 1u);
  __syncthreads();
  return *s;
}

DI void transpose_job(const float* __restrict__ src, int K, int N, u16* __restrict__ dst, int ldd, int koff,
                      const float* __restrict__ kscale, float cmul) {
  float(*tile)[65] = (float(*)[65])shm;
  const int ntn = (N + 63) / 64, ntk = K / 64, nt = ntn * ntk, tid = otid();
  for (int t = blockIdx.x; t < nt; t += gridDim.x) {
    const int tk = t % ntk, tn = t / ntk, k0 = tk * 64, n0 = tn * 64;
#pragma unroll
    for (int i = 0; i < 8; ++i) {
      const int k = (tid >> 6) + 8 * i, n = n0 + (tid & 63);
      float v = (n < N) ? src[(size_t)(k0 + k) * N + n] : 0.f;
      if (kscale) v *= kscale[k0 + k];
      tile[k][tid & 63] = v * cmul;
    }
    __syncthreads();
    {
      const int n = tid >> 3, kc = (tid & 7) * 8;
      if (n0 + n < N) {
        uint4 o;
        o.x = pack2(tile[kc + 0][n], tile[kc + 1][n]);
        o.y = pack2(tile[kc + 2][n], tile[kc + 3][n]);
        o.z = pack2(tile[kc + 4][n], tile[kc + 5][n]);
        o.w = pack2(tile[kc + 6][n], tile[kc + 7][n]);
        *(uint4*)(dst + (size_t)(n0 + n) * ldd + koff + k0 + kc) = o;
      }
    }
    __syncthreads();
  }
}

DI void phase_prologue(const Params& P) {
  char* ws = P.ws;
  for (int l = 0; l < DEPTH; ++l) {
    transpose_job(P.w_in + (size_t)l * DM * INW, DM, INW, (u16*)(ws + OFF_WINT) + (size_t)l * 11776 * 1024, 1024, 0, nullptr, 1.f);
    transpose_job(P.w_uq + (size_t)l * 256 * 576, 256, 576, (u16*)(ws + OFF_WUQT) + (size_t)l * 768 * 256, 256, 0,
                  P.qnorm + l * 256, 0.10206207261596575f * LOG2E  );
    transpose_job(P.w_ukv + (size_t)l * 128 * 768, 128, 768, (u16*)(ws + OFF_WUKVT) + (size_t)l * 768 * 128, 128, 0,
                  P.kvnorm + l * 128, 1.f);
    u16* wbr = (u16*)(ws + OFF_WBRT) + (size_t)l * 1024 * YW;
    transpose_job(P.w_br_a + (size_t)l * 384 * DM, 384, DM, wbr, YW, Y_A, nullptr, 1.f);
    transpose_job(P.w_br_b + (size_t)l * 384 * DM, 384, DM, wbr, YW, Y_B, nullptr, 1.f);
    transpose_job(P.w_br_c + (size_t)l * 512 * DM, 512, DM, wbr, YW, Y_C, nullptr, 1.f);
    transpose_job(P.w_br_d + (size_t)l * 384 * DM, 384, DM, wbr, YW, Y_D, nullptr, 1.f);
    transpose_job(P.w_out + (size_t)l * DM * DM, DM, DM, (u16*)(ws + OFF_WOUTT) + (size_t)l * DM * DM, DM, 0, nullptr, 1.f);
  }
  const int gtid = blockIdx.x * 512 + otid(), gn = gridDim.x * 512;
  u16* lruT = (u16*)(ws + OFF_LRUT);
  for (int idx = gtid; idx < DEPTH * 2 * 2 * 6 * 4096; idx += gn) {
    const int c = idx & 63, d = (idx >> 6) & 63, n = (idx >> 12) % 6, ri = ((idx >> 12) / 6) & 1, ld = (idx >> 12) / 12;
    const float* w = ri ? P.lru_wi : P.lru_wr;
    lruT[idx] = f2bf(w[((size_t)(ld * 6 + n) * 64 + c) * 64 + d]);
  }
  float* rope = (float*)(ws + OFF_ROPE);
  for (int idx = gtid; idx < SEQ * 16; idx += gn) {
    const int pos = idx >> 4, i = idx & 15;
    double f = (double)pos * P.inv[i] * 0.15915494309189533577;
    f -= rint(f);
    rope[idx * 2] = __builtin_amdgcn_cosf((float)f);
    rope[idx * 2 + 1] = __builtin_amdgcn_sinf((float)f);
  }
}

DI float wave_sum(float v) {
#pragma unroll
  for (int o = 32; o > 0; o >>= 1) v += __shfl_xor(v, o);
  return v;
}
DI void phase_norm(const Params& P, int l) {
  const int tid_ = otid(), lane = tid_ & 63, gw = blockIdx.x * 8 + (tid_ >> 6), nw = gridDim.x * 8;
  const float* xsrc = (l == 0) ? P.x : P.out;
  const float* oraw = (const float*)(P.ws + OFF_P);
  u16* hb = (u16*)(P.ws + OFF_HB);
  for (int row = gw; row < NTOK; row += nw) {
    float4 xv[4];
#pragma unroll
    for (int i = 0; i < 4; ++i) xv[i] = *(const float4*)(xsrc + (size_t)row * DM + lane * 4 + i * 256);
    if (l > 0) {
      float4 ov[4];
      float ss = 0.f;
#pragma unroll
      for (int i = 0; i < 4; ++i) {
        ov[i] = *(const float4*)(oraw + (size_t)row * DM + lane * 4 + i * 256);
        ss += ov[i].x * ov[i].x + ov[i].y * ov[i].y + ov[i].z * ov[i].z + ov[i].w * ov[i].w;
      }
      ss = wave_sum(ss);
      const float rs = rsqrtf(ss * (1.f / DM) + EPS);
#pragma unroll
      for (int i = 0; i < 4; ++i) {
        const float4 g = *(const float4*)(P.norm_post + (l - 1) * DM + lane * 4 + i * 256);
        xv[i].x += ov[i].x * rs * g.x; xv[i].y += ov[i].y * rs * g.y; xv[i].z += ov[i].z * rs * g.z; xv[i].w += ov[i].w * rs * g.w;
      }
    }
    if (l > 0 || true) {
#pragma unroll
      for (int i = 0; i < 4; ++i) *(float4*)(P.out + (size_t)row * DM + lane * 4 + i * 256) = xv[i];
    }
    if (l < DEPTH) {
      float ss = 0.f;
#pragma unroll
      for (int i = 0; i < 4; ++i) ss += xv[i].x * xv[i].x + xv[i].y * xv[i].y + xv[i].z * xv[i].z + xv[i].w * xv[i].w;
      ss = wave_sum(ss);
      const float rs = rsqrtf(ss * (1.f / DM) + EPS);
#pragma unroll
      for (int i = 0; i < 4; ++i) {
        const float4 g = *(const float4*)(P.norm_pre + l * DM + lane * 4 + i * 256);
        uint2 o;
        o.x = pack2(xv[i].x * rs * g.x, xv[i].y * rs * g.y);
        o.y = pack2(xv[i].z * rs * g.z, xv[i].w * rs * g.w);
        *(uint2*)(hb + (size_t)row * DM + lane * 4 + i * 256) = o;
      }
    }
  }
}

DI int lds_byte2(int r, int c) {
  int st = (r >> 4) * 2 + (c >> 5), ob = (r & 15) * 64 + (c & 31) * 2;
  return st * 1024 + (ob ^ (((ob >> 9) & 1) << 5));
}
DI void stage_rc2(int b, int& R, int& C) {
  int st = b >> 10, sb = b & 1023, swz = sb ^ (((sb >> 9) & 1) << 5);
  R = (st >> 1) * 16 + swz / 64;
  C = (st & 1) * 32 + (swz % 64) / 2;
}
#define WAIT_V0() asm volatile("s_waitcnt vmcnt(0)" ::: "memory")

template <int NF>
DI void gemm_tile(const u16* __restrict__ A, int lda, const u16* __restrict__ Bt, int ldb, int nt, f32x4 (&acc)[8][NF]) {
  constexpr int TILE_A = 32768, TILE_B = NF * 8192, STAGE_B = TILE_A + TILE_B;
  const int tid = otid(), wid = tid >> 6, lane = tid & 63, wr = wid >> 2, wc = wid & 3, fr = lane & 15, fq = lane >> 4;
  int sR[4], sC[4];
#pragma unroll
  for (int i = 0; i < 4; ++i) stage_rc2(wid * 1024 + i * 8192 + lane * 16, sR[i], sC[i]);
#define SA_(b) (shm + (b) * STAGE_B)
#define SB_(b) (shm + (b) * STAGE_B + TILE_A)
#define GSTAGE(buf, kt)                                                                                              \
  do {                                                                                                               \
    _Pragma("unroll") for (int i = 0; i < 4; ++i)                                                                    \
      __builtin_amdgcn_global_load_lds((const unsigned*)(A + (size_t)sR[i] * lda + (kt) * 64 + sC[i]),              \
                                       LDSP(unsigned, SA_(buf) + wid * 1024 + i * 8192), 16, 0, 0);                  \
    _Pragma("unroll") for (int i = 0; i < NF; ++i)                                                                   \
      __builtin_amdgcn_global_load_lds((const unsigned*)(Bt + (size_t)sR[i] * ldb + (kt) * 64 + sC[i]),             \
                                       LDSP(unsigned, SB_(buf) + wid * 1024 + i * 8192), 16, 0, 0);                  \
  } while (0)
  GSTAGE(0, 0);
  WAIT_V0();
  __syncthreads();
#pragma unroll 1
  for (int t = 0; t < nt; ++t) {
    const int cur = t & 1;
    if (t + 1 < nt) GSTAGE(cur ^ 1, t + 1);
#pragma unroll
    for (int ks = 0; ks < 2; ++ks) {
      bf16x8 At[8], Bf[NF];
#pragma unroll
      for (int m = 0; m < 8; ++m) At[m] = *(const bf16x8*)(SA_(cur) + lds_byte2(wr * 128 + m * 16 + fr, ks * 32 + fq * 8));
#pragma unroll
      for (int n = 0; n < NF; ++n) Bf[n] = *(const bf16x8*)(SB_(cur) + lds_byte2(wc * 16 * NF + n * 16 + fr, ks * 32 + fq * 8));
#pragma unroll
      for (int m = 0; m < 8; ++m)
#pragma unroll
        for (int n = 0; n < NF; ++n) acc[m][n] = MFMA16(Bf[n], At[m], acc[m][n]);
      __builtin_amdgcn_sched_barrier(0);
    }
    WAIT_V0();
    __syncthreads();
  }
#undef SA_
#undef SB_
#undef GSTAGE
}

DI void tile_remap(int t, int nM, int nN, int& pm, int& pn) {
  const int nwg = nM * nN;
  int q = nwg / 8, r = nwg % 8, xcd = t % 8, off = t / 8;
  int w = (xcd < r ? xcd * (q + 1) : r * (q + 1) + (xcd - r) * q) + off;
  int nig = 8 * nN, gid = w / nig, fm = gid * 8, gsz = min(nM - fm, 8);
  pm = fm + ((w % nig) % gsz);
  pn = (w % nig) / gsz;
}

DI void phase_inproj(const Params& P, int l) {
  const u16* hb = (const u16*)(P.ws + OFF_HB);
  const u16* wT = (const u16*)(P.ws + OFF_WINT) + (size_t)l * 11776 * 1024;
  u16* p = (u16*)(P.ws + OFF_P);
  const int tid = otid(), wid = tid >> 6, lane = tid & 63, wr = wid >> 2, wc = wid & 3, fr = lane & 15, fq = lane >> 4;
  const int nM = 64, nN = 46;
  for (int t = blockIdx.x; t < nM * nN; t += gridDim.x) {
    int pm, pn;
    tile_remap(t, nM, nN, pm, pn);
    f32x4 acc[8][4];
#pragma unroll
    for (int m = 0; m < 8; ++m)
#pragma unroll
      for (int n = 0; n < 4; ++n) acc[m][n] = f32x4{0.f, 0.f, 0.f, 0.f};
    gemm_tile<4>(hb + (size_t)pm * 256 * DM, DM, wT + (size_t)pn * 256 * DM, DM, DM / 64, acc);
#pragma unroll
    for (int n = 0; n < 4; ++n) {
      const int col0 = pn * 256 + wc * 64 + n * 16;
      if (col0 >= INW) continue;
      int kind = 0;
      if (col0 < C_AK) kind = 1;
      else if (col0 >= C_CQ && col0 < C_CK) kind = 1;
      else if ((col0 >= C_AG && col0 < C_BX) || (col0 >= C_BG && col0 < C_CQ) || (col0 >= C_CG && col0 < C_DCQ) ||
               (col0 >= C_DG && col0 < C_GATE)) kind = 2;
      else if (col0 >= C_GATE) kind = 3;
      float4 bg = float4{0.f, 0.f, 0.f, 0.f};
      if (kind == 3) bg = *(const float4*)(P.b_gate + l * 4096 + col0 - C_GATE + fq * 4);
#pragma unroll
      for (int m = 0; m < 8; ++m) {
        const size_t row = (size_t)pm * 256 + wr * 128 + m * 16 + fr;
        float v0 = acc[m][n][0], v1 = acc[m][n][1], v2 = acc[m][n][2], v3 = acc[m][n][3];
        if (kind == 1) { v0 *= QSC; v1 *= QSC; v2 *= QSC; v3 *= QSC; }
        else if (kind == 2) { v0 = siluf_(v0); v1 = siluf_(v1); v2 = siluf_(v2); v3 = siluf_(v3); }
        else if (kind == 3) { v0 = sigmoidf_(v0 + bg.x); v1 = sigmoidf_(v1 + bg.y); v2 = sigmoidf_(v2 + bg.z); v3 = sigmoidf_(v3 + bg.w); }
        *(uint2*)(p + row * INW + col0 + fq * 4) = uint2{pack2(v0, v1), pack2(v2, v3)};
      }
    }
  }
}

DI float half_max(float x) {
  auto r = __builtin_amdgcn_permlane32_swap(__float_as_uint(x), __float_as_uint(x), false, false);
  return fmaxf(__uint_as_float(r[0]), __uint_as_float(r[1]));
}
DI float half_sum(float x) {
  auto r = __builtin_amdgcn_permlane32_swap(__float_as_uint(x), __float_as_uint(x), false, false);
  return __uint_as_float(r[0]) + __uint_as_float(r[1]);
}
template <int DQK>
DI void qk_tile(const bf16x8 (&qf)[DQK / 16], const char* Kt, int KP, f32x16 (&s)[2], int lane) {
  const int r = lane & 31, h = lane >> 5;
#pragma unroll
  for (int sub = 0; sub < 2; ++sub) {
#pragma unroll
    for (int i = 0; i < 16; ++i) s[sub][i] = 0.f;
#pragma unroll
    for (int ks = 0; ks < DQK / 16; ++ks) {
      const bf16x8 kf = *(const bf16x8*)(Kt + (sub * 32 + r) * KP + ks * 32 + h * 16);
      s[sub] = MFMA32(kf, qf[ks], s[sub]);
    }
  }
}
template <int DV, typename BiasF>
DI void softmax_pv(f32x16 (&s)[2], const char* Vt, int VP, f32x16 (&o)[DV / 32], float& m, float& lsum, BiasF bias, int lane) {
  const int h = lane >> 5;
  float tmax = -INFINITY;
#pragma unroll
  for (int sub = 0; sub < 2; ++sub)
#pragma unroll
    for (int i = 0; i < 16; ++i) {
      const float v = bias(sub * 32 + crow(i, h), s[sub][i]);
      s[sub][i] = v;
      tmax = fmaxf(tmax, v);
    }
  tmax = half_max(tmax);
  const float m_new = fmaxf(m, tmax);
  const float m_safe = (m_new == -INFINITY) ? 0.f : m_new;
  const float alpha = __builtin_amdgcn_exp2f(m - m_safe);
  float psum = 0.f;
#pragma unroll
  for (int sub = 0; sub < 2; ++sub)
#pragma unroll
    for (int i = 0; i < 16; ++i) {
      const float pv = __builtin_amdgcn_exp2f(s[sub][i] - m_safe);
      s[sub][i] = pv;
      psum += pv;
    }
  psum = half_sum(psum);
  lsum = lsum * alpha + psum;
  m = m_new;
  if (__builtin_amdgcn_ballot_w64(alpha != 1.f) != 0) {
#pragma unroll
    for (int mt = 0; mt < DV / 32; ++mt)
#pragma unroll
      for (int i = 0; i < 16; ++i) o[mt][i] *= alpha;
  }
  const int i16 = lane & 15, q4 = i16 >> 2, p4 = i16 & 3, blk = (lane >> 4) & 1;
#pragma unroll
  for (int kk = 0; kk < 4; ++kk) {
    const int sub = kk >> 1, s2 = kk & 1;
    u32x4 pu;
#pragma unroll
    for (int jj = 0; jj < 4; ++jj) pu[jj] = pack2(s[sub][8 * s2 + 2 * jj], s[sub][8 * s2 + 2 * jj + 1]);
    const bf16x8 pfv = __builtin_bit_cast(bf16x8, pu);
#pragma unroll
    for (int mt = 0; mt < DV / 32; ++mt) {
      const char* vb = Vt + (kk * 16 + 4 * h + q4) * VP + (mt * 32 + 16 * blk + 4 * p4) * 2;
      const s16x4 lo = __builtin_amdgcn_ds_read_tr16_b64_v4i16(LDSP(s16x4, vb));
      const s16x4 hi = __builtin_amdgcn_ds_read_tr16_b64_v4i16(LDSP(s16x4, vb + 8 * VP));
      const bf16x8 vf = __builtin_shufflevector(lo, hi, 0, 1, 2, 3, 4, 5, 6, 7);
      o[mt] = MFMA32(vf, pfv, o[mt]);
    }
  }
}

template <int DQK, int DV, typename BiasF>
DI void flash_tile(const bf16x8 (&qf)[DQK / 16], const char* Kt, int KP, const char* Vt, int VP, f32x16 (&o)[DV / 32],
                   float& m, float& lsum, BiasF bias) {
  const int lane = otid() & 63;
  f32x16 s[2];
  qk_tile<DQK>(qf, Kt, KP, s, lane);
  softmax_pv<DV>(s, Vt, VP, o, m, lsum, bias, lane);
}

DI void a_attn_item(const Params& P, int item) {
  const u16* p = (const u16*)(P.ws + OFF_P);
  u16* Ao = (u16*)(P.ws + OFF_AO);
  float* Alse = (float*)(P.ws + OFF_ALSE);
  const int tid = otid(), lane = tid & 63, w = tid >> 6, r32 = lane & 31, h = lane >> 5;
  const int u = item * 8 + w;
  const int half = u & 1, nbr = (u >> 1) & 63, hi = u >> 7, slot = hi % 6, g = (hi / 6) % 3, b = hi / 18;
  const int dil = (g == 0) ? 1 : (g == 1 ? 4 : 16);
  const int L = SEQ / dil, res = nbr % dil, l0 = (nbr / dil) * 64;
  const float slope = exp2f(-8.f * (float)(slot + 1) / 6.f) * (float)dil * LOG2E;
  const int lq = l0 + half * 32 + r32;
  const size_t qrow = (size_t)b * SEQ + res + dil * lq;
  bf16x8 qf[4];
#pragma unroll
  for (int ks = 0; ks < 4; ++ks) qf[ks] = *(const bf16x8*)(p + qrow * INW + C_AQ + g * 384 + slot * 64 + ks * 16 + h * 8);
  char* Kw = shm + w * 18432;
  char* Vw = Kw + 9216;
  f32x16 o[2];
#pragma unroll
  for (int mt = 0; mt < 2; ++mt)
#pragma unroll
    for (int i = 0; i < 16; ++i) o[mt][i] = 0.f;
  float m = -INFINITY, lsum = 0.f;
  for (int kt = 0; kt < 3; ++kt) {
    const int lk0 = l0 - 64 + kt * 64;
    uint4 kv[8], vv[8];
#pragma unroll
    for (int i = 0; i < 8; ++i) {
      const int idx = lane + 64 * i, rr = idx >> 3, ch = idx & 7, lk = lk0 + rr;
      const bool valid = (lk >= 0) && (lk < L);
      const size_t krow = (size_t)b * SEQ + res + dil * (valid ? lk : 0);
      const u16* src = p + krow * INW + g * 384 + slot * 64 + ch * 8;
      kv[i] = valid ? *(const uint4*)(src + C_AK) : uint4{0, 0, 0, 0};
      vv[i] = valid ? *(const uint4*)(src + C_AV) : uint4{0, 0, 0, 0};
    }
    __builtin_amdgcn_wave_barrier();
#pragma unroll
    for (int i = 0; i < 8; ++i) {
      const int idx = lane + 64 * i, rr = idx >> 3, ch = idx & 7;
      *(uint4*)(Kw + rr * 144 + ch * 16) = kv[i];
      *(uint4*)(Vw + rr * 144 + ch * 16) = vv[i];
    }
    __builtin_amdgcn_wave_barrier();
    flash_tile<64, 64>(qf, Kw, 144, Vw, 144, o, m, lsum, [&](int key, float v) {
      const int lk = lk0 + key, rel = lk - lq, ar = rel < 0 ? -rel : rel;
      const bool ok = (ar <= 64) && (lk >= 0) && (lk < L);
      return ok ? v - slope * (float)ar : -INFINITY;
    });
    __builtin_amdgcn_wave_barrier();
  }
  const float inv = 1.f / lsum;
#pragma unroll
  for (int mt = 0; mt < 2; ++mt)
#pragma unroll
    for (int g4 = 0; g4 < 4; ++g4) {
      uint2 ov;
      ov.x = pack2(o[mt][4 * g4] * inv, o[mt][4 * g4 + 1] * inv);
      ov.y = pack2(o[mt][4 * g4 + 2] * inv, o[mt][4 * g4 + 3] * inv);
      *(uint2*)(Ao + ((size_t)g * NTOK + qrow) * 384 + slot * 64 + mt * 32 + 8 * g4 + 4 * h) = ov;
    }
  if (h == 0) Alse[((size_t)g * NTOK + qrow) * 6 + slot] = m + __log2f(lsum);
}

DI void a_combine_item(const Params& P, int item) {
  const u16* p = (const u16*)(P.ws + OFF_P);
  const u16* Ao = (const u16*)(P.ws + OFF_AO);
  const float* Alse = (const float*)(P.ws + OFF_ALSE);
  u16* Y = (u16*)(P.ws + OFF_Y);
  for (int idx = otid(); idx < 128 * 48; idx += 512) {
    const size_t tok = (size_t)item * 128 + idx / 48;
    const int sc = idx % 48, slot = sc >> 3, d0 = (sc & 7) * 8;
    const float l0 = Alse[(0 * (size_t)NTOK + tok) * 6 + slot], l1 = Alse[(1 * (size_t)NTOK + tok) * 6 + slot],
                l2 = Alse[(2 * (size_t)NTOK + tok) * 6 + slot];
    const float mx = fmaxf(l0, fmaxf(l1, l2));
    float w0 = exp2f(l0 - mx), w1 = exp2f(l1 - mx), w2 = exp2f(l2 - mx);
    const float ws_ = 1.f / (w0 + w1 + w2);
    w0 *= ws_; w1 *= ws_; w2 *= ws_;
    const uint4 a0 = *(const uint4*)(Ao + (0 * (size_t)NTOK + tok) * 384 + slot * 64 + d0);
    const uint4 a1 = *(const uint4*)(Ao + (1 * (size_t)NTOK + tok) * 384 + slot * 64 + d0);
    const uint4 a2 = *(const uint4*)(Ao + (2 * (size_t)NTOK + tok) * 384 + slot * 64 + d0);
    const uint4 gg = *(const uint4*)(p + tok * INW + C_AG + slot * 64 + d0);
    const unsigned* pa0 = (const unsigned*)&a0; const unsigned* pa1 = (const unsigned*)&a1; const unsigned* pa2 = (const unsigned*)&a2;
    const unsigned* pg = (const unsigned*)&gg;
    unsigned ov[4];
#pragma unroll
    for (int j = 0; j < 4; ++j) {
      const float lo = (w0 * bf2f(pa0[j] & 0xffff) + w1 * bf2f(pa1[j] & 0xffff) + w2 * bf2f(pa2[j] & 0xffff)) * bf2f(pg[j] & 0xffff);
      const float hi = (w0 * bf2f(pa0[j] >> 16) + w1 * bf2f(pa1[j] >> 16) + w2 * bf2f(pa2[j] >> 16)) * bf2f(pg[j] >> 16);
      ov[j] = pack2(lo, hi);
    }
    *(uint4*)(Y + tok * YW + Y_A + slot * 64 + d0) = uint4{ov[0], ov[1], ov[2], ov[3]};
  }
}

DI void b_item(const Params& P, int l, int item, int mode) {
  const u16* p = (const u16*)(P.ws + OFF_P);
  float* sA = (float*)(P.ws + OFF_SA);
  float* sU = (float*)(P.ws + OFF_SU);
  u16* Y = (u16*)(P.ws + OFF_Y);
  const u16* lruT = (const u16*)(P.ws + OFF_LRUT);
  const int tid = otid(), lane = tid & 63, w = tid >> 6;
  const int n = item % 6, ck = (item / 6) & 63, b = item / 384;
  const int t0 = ck * 64;
  float(*xs)[64] = (float(*)[64])(shm);
  float(*xcf)[64] = (float(*)[64])(shm + 17408);
  u16(*xcb)[72] = (u16(*)[72])(shm + 33792);
  float(*gt)[64][64] = (float(*)[64][64])(shm + 43008);
  float(*hs)[64][64] = (float(*)[64][64])(shm + 108544);
  (void)hs;
  float* spv = (float*)(shm + 141312);
  float* cin = (float*)(shm + 141824);
  if (mode == 1) {
    float* la = (float*)(shm + 43008);
    {
      float tmp[32];
#pragma unroll
      for (int i = 0; i < 32; ++i) {
        const int idx = tid + 512 * i;
        const int k = idx >> 8, r = idx & 255, isu = r >> 7, dd = r & 127, dir = dd >> 6, d = dd & 63;
        const size_t si = ((size_t)(b * 64 + k) * 2 + dir) * 384 + n * 64 + d;
        tmp[i] = isu ? sU[si] : sA[si];
      }
#pragma unroll
      for (int i = 0; i < 32; ++i) la[tid + 512 * i] = tmp[i];
    }
    __syncthreads();
    if (tid < 128) {
      const int dir = tid >> 6;
      float hc = 0.f;
      if (dir == 0) {
        for (int k = 0; k < ck; ++k) hc = la[k * 256 + tid] * hc + la[k * 256 + 128 + tid];
      } else {
        for (int k = 63; k > ck; --k) hc = la[k * 256 + tid] * hc + la[k * 256 + 128 + tid];
      }
      cin[tid] = hc;
    }
  }
  {
    u16 tmp[9];
#pragma unroll
    for (int i = 0; i < 9; ++i) {
      const int idx = tid + 512 * i, rr = idx >> 6, c = idx & 63, t = t0 - 1 + rr;
      tmp[i] = (idx < 67 * 64 && t >= 0 && t < SEQ) ? p[((size_t)b * SEQ + t) * INW + C_BX + n * 64 + c] : (u16)0;
    }
#pragma unroll
    for (int i = 0; i < 9; ++i) {
      const int idx = tid + 512 * i, rr = idx >> 6, c = idx & 63;
      if (idx < 67 * 64) xs[rr][c] = bf2f(tmp[i]);
    }
  }
  const int cch = n * 64 + (tid & 63);
  const float* cwp = P.conv_w + (size_t)l * 4 * 384 + cch;
  const float cw0 = cwp[0], cw1 = cwp[384], cw2 = cwp[768], cw3 = cwp[1152], cbv = P.conv_b[l * 384 + cch];
  __syncthreads();
#pragma unroll
  for (int i = 0; i < 8; ++i) {
    const int idx = tid + 512 * i, t = idx >> 6, c = idx & 63;
    const float v = cbv + cw0 * xs[t][c] + cw1 * xs[t + 1][c] + cw2 * xs[t + 2][c] + cw3 * xs[t + 3][c];
    xcf[t][c] = v;
    xcb[t][c] = f2bf(v);
  }
  __syncthreads();
  {
    const int mat = w & 3, dir = mat >> 1, ri = mat & 1, th = w >> 2, r32 = lane & 31, h = lane >> 5;
    f32x16 acc[2];
#pragma unroll
    for (int nt2 = 0; nt2 < 2; ++nt2)
#pragma unroll
      for (int i = 0; i < 16; ++i) acc[nt2][i] = 0.f;
    const u16* wb = lruT + ((size_t)(((l * 2 + dir) * 2 + ri) * 6 + n) * 64) * 64;
#pragma unroll
    for (int ks = 0; ks < 4; ++ks) {
      const bf16x8 a = *(const bf16x8*)(&xcb[th * 32 + r32][ks * 16 + h * 8]);
#pragma unroll
      for (int nt2 = 0; nt2 < 2; ++nt2) {
        const bf16x8 bb = *(const bf16x8*)(wb + (size_t)(nt2 * 32 + r32) * 64 + ks * 16 + h * 8);
        acc[nt2] = MFMA32(a, bb, acc[nt2]);
      }
    }
    const float* bias = (ri ? P.lru_bi : P.lru_br) + (l * 2 + dir) * 384 + n * 64;
#pragma unroll
    for (int nt2 = 0; nt2 < 2; ++nt2) {
      const int d = nt2 * 32 + r32;
      const float bv = bias[d];
#pragma unroll
      for (int i = 0; i < 16; ++i) gt[mat][th * 32 + crow(i, h)][d] = sigmoidf_(acc[nt2][i] + bv);
    }
  }
  __syncthreads();
  if (tid < 128) {
    const int dir = tid >> 6, d = tid & 63;
    const float lam = P.lru_lambda[(l * 2 + dir) * 384 + n * 64 + d];
    spv[tid] = log1pf(__expf(-lam));
  }
  __syncthreads();
  for (int idx = tid; idx < 2 * 64 * 64; idx += 512) {
    const int dir = idx >> 12, t = (idx >> 6) & 63, d = idx & 63;
    const float rg = gt[dir * 2][t][d], ig = gt[dir * 2 + 1][t][d];
    const float log_a = -8.f * rg * spv[dir * 64 + d];
    const float x2 = 2.f * log_a;
    const float a = __expf(log_a);
    const float om = (x2 > -0.0625f) ? -x2 * (1.f + x2 * (0.5f + x2 * (0.16666667f + x2 * 0.041666668f))) : 1.f - __expf(x2);
    const float u = __builtin_amdgcn_sqrtf(fmaxf(om, 0.f)) * (ig * xcf[t][d]);
    gt[dir * 2][t][d] = a;
    gt[dir * 2 + 1][t][d] = u;
  }
  __syncthreads();
  if (tid < 128) {
    const int dir = tid >> 6, d = tid & 63, ch = n * 64 + d;
    float hcar = (mode == 1) ? cin[tid] : 0.f, pp = 1.f;
#pragma unroll 1
    for (int tb = 0; tb < 64; tb += 16) {
      float av[16], uv[16];
#pragma unroll
      for (int j = 0; j < 16; ++j) {
        const int t = dir ? 63 - (tb + j) : tb + j;
        av[j] = gt[dir * 2][t][d];
        uv[j] = gt[dir * 2 + 1][t][d];
      }
#pragma unroll
      for (int j = 0; j < 16; ++j) {
        const int t = dir ? 63 - (tb + j) : tb + j;
        hcar = av[j] * hcar + uv[j];
        pp *= av[j];
        if (mode == 1) gt[dir * 2][t][d] = hcar;
      }
    }
    if (mode == 0) {
      const size_t si = ((size_t)(b * 64 + ck) * 2 + dir) * 384 + ch;
      sA[si] = pp;
      sU[si] = hcar;
    }
  }
  if (mode == 1) {
    __syncthreads();
    u16 gb[8];
#pragma unroll
    for (int i = 0; i < 8; ++i) {
      const int idx = tid + 512 * i, t = idx >> 6, c = idx & 63;
      gb[i] = p[((size_t)b * SEQ + t0 + t) * INW + C_BG + n * 64 + c];
    }
#pragma unroll
    for (int i = 0; i < 8; ++i) {
      const int idx = tid + 512 * i, t = idx >> 6, c = idx & 63;
      const size_t tok = (size_t)b * SEQ + t0 + t;
      Y[tok * YW + Y_B + n * 64 + c] = f2bf((gt[0][t][c] + gt[2][t][c]) * bf2f(gb[i]));
    }
  }
}

template <bool isq>
DI void dprep_item(const Params& P, int l, int item) {
  const u16* p = (const u16*)(P.ws + OFF_P);
  u16* Dq = (u16*)(P.ws + OFF_DQ);
  u16* Dk = (u16*)(P.ws + OFF_DK);
  u16* Dv = (u16*)(P.ws + OFF_DV);
  const float* rope = (const float*)(P.ws + OFF_ROPE);
  const int tid = otid(), wid = tid >> 6, lane = tid & 63, wr = wid >> 2, wc = wid & 3, fr = lane & 15, fq = lane >> 4;
  const int it = item, pm = it / 3, pn = it % 3;
  constexpr int K = isq ? 256 : 128;
  const u16* A = p + (size_t)pm * 256 * INW + (isq ? C_DCQ : C_DCKV);
  const u16* Bt = (isq ? (const u16*)(P.ws + OFF_WUQT) : (const u16*)(P.ws + OFF_WUKVT)) + (size_t)l * 768 * K + (size_t)pn * 256 * K;
  float* rsq = (float*)(shm + 131072);
  {
    const int row = tid >> 1, hf = tid & 1;
    const u16* src = A + (size_t)row * INW + hf * (K / 2);
    float ss = 0.f;
    for (int c = 0; c < K / 2; c += 8) {
      const uint4 v = *(const uint4*)(src + c);
      const unsigned* pv = (const unsigned*)&v;
#pragma unroll
      for (int j = 0; j < 4; ++j) {
        const float a = bf2f(pv[j] & 0xffff), bq = bf2f(pv[j] >> 16);
        ss += a * a + bq * bq;
      }
    }
    ss += __shfl_xor(ss, 1);
    if (!hf) rsq[row] = rsqrtf(ss / (float)K + EPS);
  }
  __syncthreads();
  f32x4 acc[8][4];
#pragma unroll
  for (int m = 0; m < 8; ++m)
#pragma unroll
    for (int n = 0; n < 4; ++n) acc[m][n] = f32x4{0.f, 0.f, 0.f, 0.f};
  gemm_tile<4>(A, INW, Bt, K, K / 64, acc);
  if (isq) {
#pragma unroll
    for (int n = 0; n < 4; ++n) {
      const int col0 = pn * 256 + wc * 64 + n * 16;
      if (col0 >= 576) continue;
      const int hh = col0 / 96, e0 = col0 % 96;
      if (e0 == 80) continue;
#pragma unroll
      for (int m = 0; m < 8; ++m) {
        const int rl = wr * 128 + m * 16 + fr;
        const size_t row = (size_t)pm * 256 + rl;
        const float rs = rsq[rl];
        const float v0 = acc[m][n][0] * rs, v1 = acc[m][n][1] * rs, v2 = acc[m][n][2] * rs, v3 = acc[m][n][3] * rs;
        if (e0 == 64) {
          const float x0 = acc[m][(n + 1) & 3][0] * rs, x1 = acc[m][(n + 1) & 3][1] * rs, x2 = acc[m][(n + 1) & 3][2] * rs,
                      x3 = acc[m][(n + 1) & 3][3] * rs;
          const int pos = (int)(row & (SEQ - 1));
          const float4 ca = *(const float4*)(rope + (pos * 16 + fq * 4) * 2);
          const float4 cb = *(const float4*)(rope + (pos * 16 + fq * 4) * 2 + 4);
          *(uint2*)(Dq + row * 576 + hh * 96 + 64 + fq * 4) =
              uint2{pack2(v0 * ca.x - x0 * ca.y, v1 * ca.z - x1 * ca.w), pack2(v2 * cb.x - x2 * cb.y, v3 * cb.z - x3 * cb.w)};
          *(uint2*)(Dq + row * 576 + hh * 96 + 80 + fq * 4) =
              uint2{pack2(v0 * ca.y + x0 * ca.x, v1 * ca.w + x1 * ca.z), pack2(v2 * cb.y + x2 * cb.x, v3 * cb.w + x3 * cb.z)};
        } else {
          *(uint2*)(Dq + row * 576 + hh * 96 + e0 + fq * 4) = uint2{pack2(v0, v1), pack2(v2, v3)};
        }
      }
    }
  } else {
#pragma unroll
    for (int n = 0; n < 4; ++n) {
      const int col0 = pn * 256 + wc * 64 + n * 16;
      const int hh = col0 / 128, e0 = col0 % 128;
#pragma unroll
      for (int m = 0; m < 8; ++m) {
        const int rl = wr * 128 + m * 16 + fr;
        const size_t row = (size_t)pm * 256 + rl;
        const float rs = rsq[rl];
        const uint2 ov = uint2{pack2(acc[m][n][0] * rs, acc[m][n][1] * rs), pack2(acc[m][n][2] * rs, acc[m][n][3] * rs)};
        if (e0 < 64) *(uint2*)(Dk + row * 576 + hh * 96 + e0 + fq * 4) = ov;
        else *(uint2*)(Dv + row * 384 + hh * 64 + (e0 - 64) + fq * 4) = ov;
      }
    }
    if (pn == 0) {
      for (int idx = tid; idx < 256 * 16; idx += 512) {
        const int rl = idx >> 4, i = idx & 15;
        const size_t row = (size_t)pm * 256 + rl;
        const float x1 = bf2f(p[row * INW + C_DKR + i]), x2 = bf2f(p[row * INW + C_DKR + 16 + i]);
        const int pos = (int)(row & (SEQ - 1));
        const float c = rope[(pos * 16 + i) * 2], s = rope[(pos * 16 + i) * 2 + 1];
        const u16 o1 = f2bf(x1 * c - x2 * s), o2 = f2bf(x1 * s + x2 * c);
#pragma unroll
        for (int hh = 0; hh < 6; ++hh) {
          Dk[row * 576 + hh * 96 + 64 + i] = o1;
          Dk[row * 576 + hh * 96 + 80 + i] = o2;
        }
      }
    }
  }
}

DI void c_attn_item(const Params& P, int l, int item) {
  const u16* p = (const u16*)(P.ws + OFF_P);
  u16* Y = (u16*)(P.ws + OFF_Y);
  const int tid = otid(), lane = tid & 63, w = tid >> 6, r32 = lane & 31, h = lane >> 5;
  const int qb = item & 31, hh = (item >> 5) & 3, b = item >> 7;
  const int cmap = w >> 2, q0 = qb * 128 + (w & 3) * 32;
  const size_t qrow = (size_t)b * SEQ + q0 + r32;
  const float slope = exp2f(-2.f * (float)(hh + 1)) * LOG2E;
  bf16x8 qf[4];
#pragma unroll
  for (int ks = 0; ks < 4; ++ks) qf[ks] = *(const bf16x8*)(p + qrow * INW + C_CQ + hh * 128 + cmap * 64 + ks * 16 + h * 8);
  constexpr int KP = 272;
  f32x16 o[4];
#pragma unroll
  for (int mt = 0; mt < 4; ++mt)
#pragma unroll
    for (int i = 0; i < 16; ++i) o[mt][i] = 0.f;
  float m = -INFINITY, lsum = 0.f;
  const u16* kvbase = p + (size_t)b * SEQ * INW + hh * 128;
  uint4 k0r, k1r, v0r, v1r;
  const int crr = tid >> 4, cch = tid & 15;
  const u16* g0 = kvbase + (size_t)crr * INW + cch * 8;
  char* lk = shm + crr * KP + cch * 16;
  char* lv = shm + 2 * 64 * KP + crr * KP + cch * 16;
#define KLOAD(kt) do { k0r = *(const uint4*)(g0 + (size_t)(kt) * 64 * INW + C_CK); k1r = *(const uint4*)(g0 + (size_t)((kt) * 64 + 32) * INW + C_CK); } while (0)
#define VLOAD(kt) do { v0r = *(const uint4*)(g0 + (size_t)(kt) * 64 * INW + C_CV); v1r = *(const uint4*)(g0 + (size_t)((kt) * 64 + 32) * INW + C_CV); } while (0)
#define KSTORE(buf) do { *(uint4*)(lk + (buf) * 64 * KP) = k0r; *(uint4*)(lk + (buf) * 64 * KP + 32 * KP) = k1r; } while (0)
#define VSTORE(buf) do { *(uint4*)(lv + (buf) * 64 * KP) = v0r; *(uint4*)(lv + (buf) * 64 * KP + 32 * KP) = v1r; } while (0)
  KLOAD(0); VLOAD(0);
  KSTORE(0); VSTORE(0);
  KLOAD(1);
  KSTORE(1);
  __syncthreads();
  const float qpos = (float)(q0 + r32);
  f32x16 sc[2];
  qk_tile<64>(qf, shm + cmap * 128, KP, sc, lane);
#pragma unroll 1
  for (int kt = 0; kt < 64; ++kt) {
    const int cur = kt & 1;
    if (kt + 2 < 64) KLOAD(kt + 2);
    if (kt + 1 < 64) VLOAD(kt + 1);
    f32x16 sn[2];
    qk_tile<64>(qf, shm + (cur ^ 1) * 64 * KP + cmap * 128, KP, sn, lane);
    const float kbase = (float)(kt * 64);
    softmax_pv<128>(sc, shm + 2 * 64 * KP + cur * 64 * KP, KP, o, m, lsum,
                    [&](int key, float v) { return v - slope * fabsf(qpos - (kbase + (float)key)); }, lane);
    if (kt + 2 < 64) KSTORE(cur);
    if (kt + 1 < 64) VSTORE(cur ^ 1);
    __syncthreads();
#pragma unroll
    for (int sub = 0; sub < 2; ++sub) sc[sub] = sn[sub];
  }
#undef KLOAD
#undef VLOAD
#undef KSTORE
#undef VSTORE
  constexpr int STG = 2 * 64 * KP;
  float* ex = (float*)(shm + 2 * STG);
  const float inv = 1.f / lsum;
  if (cmap == 1) {
#pragma unroll
    for (int mt = 0; mt < 4; ++mt)
#pragma unroll
      for (int i = 0; i < 16; ++i) ex[((w & 3) * 64 + mt * 16 + i) * 64 + lane] = o[mt][i] * inv;
  }
  __syncthreads();
  if (cmap == 0) {
    float d1 = 0.f, d2 = 0.f;
    {
      const float a1 = P.lq1[l * 64 + lane] * P.lk1[l * 64 + lane], a2 = P.lq2[l * 64 + lane] * P.lk2[l * 64 + lane];
      d1 = wave_sum(a1);
      d2 = wave_sum(a2);
    }
    const float lam_init = 0.8f - 0.6f * expf(-0.3f * (float)l);
    const float lam = expf(d1) - expf(d2) + lam_init;
    float ss = 0.f;
#pragma unroll
    for (int mt = 0; mt < 4; ++mt)
#pragma unroll
      for (int i = 0; i < 16; ++i) {
        const float dv = o[mt][i] * inv - lam * ex[((w & 3) * 64 + mt * 16 + i) * 64 + lane];
        o[mt][i] = dv;
        ss += dv * dv;
      }
    ss += __shfl_xor(ss, 32);
    const float rs = rsqrtf(ss * (1.f / 128.f) + EPS) * (1.f - lam_init);
#pragma unroll
    for (int mt = 0; mt < 4; ++mt)
#pragma unroll
      for (int g4 = 0; g4 < 4; ++g4) {
        const int dv0 = mt * 32 + 8 * g4 + 4 * h;
        const float4 sg = *(const float4*)(P.subln + l * 128 + dv0);
        const uint2 gg = *(const uint2*)(p + qrow * INW + C_CG + hh * 128 + dv0);
        uint2 ov;
        ov.x = pack2(o[mt][4 * g4] * rs * sg.x * bf2f(gg.x & 0xffff), o[mt][4 * g4 + 1] * rs * sg.y * bf2f(gg.x >> 16));
        ov.y = pack2(o[mt][4 * g4 + 2] * rs * sg.z * bf2f(gg.y & 0xffff), o[mt][4 * g4 + 3] * rs * sg.w * bf2f(gg.y >> 16));
        *(uint2*)(Y + qrow * YW + Y_C + hh * 128 + dv0) = ov;
      }
  }
}

DI void d_attn_item(const Params& P, int item) {
  const u16* p = (const u16*)(P.ws + OFF_P);
  const u16* Dq = (const u16*)(P.ws + OFF_DQ);
  const u16* Dk = (const u16*)(P.ws + OFF_DK);
  const u16* Dv = (const u16*)(P.ws + OFF_DV);
  u16* Y = (u16*)(P.ws + OFF_Y);
  const int tid = otid(), lane = tid & 63, w = tid >> 6, r32 = lane & 31, h = lane >> 5;
  const int qb = item & 15, hh = (item >> 4) % 6, b = (item >> 4) / 6;
  const size_t qrow = (size_t)b * SEQ + qb * 256 + w * 32 + r32;
  bf16x8 qf[6];
#pragma unroll
  for (int ks = 0; ks < 6; ++ks) qf[ks] = *(const bf16x8*)(Dq + qrow * 576 + hh * 96 + ks * 16 + h * 8);
  constexpr int KP = 208, VP = 144;
  f32x16 o[2];
#pragma unroll
  for (int mt = 0; mt < 2; ++mt)
#pragma unroll
    for (int i = 0; i < 16; ++i) o[mt][i] = 0.f;
  float m = -INFINITY, lsum = 0.f;
  const u16* kb = Dk + (size_t)b * SEQ * 576 + hh * 96;
  const u16* vb = Dv + (size_t)b * SEQ * 384 + hh * 64;
  uint4 k0r, k1r = uint4{0, 0, 0, 0}, v0r;
  const bool hask1 = tid < 256;
  const int kr0 = tid / 12, kc0 = tid % 12, kr1 = (tid + 512) / 12, kc1 = (tid + 512) % 12, vr = tid >> 3, vc = tid & 7;
  const u16* gk0 = kb + (size_t)kr0 * 576 + kc0 * 8;
  const u16* gk1 = kb + (size_t)kr1 * 576 + kc1 * 8;
  const u16* gv0 = vb + (size_t)vr * 384 + vc * 8;
  char* lk0 = shm + kr0 * KP + kc0 * 16;
  char* lk1 = shm + kr1 * KP + kc1 * 16;
  char* lv0 = shm + 2 * 64 * KP + vr * VP + vc * 16;
#define KLOAD(kt) do { k0r = *(const uint4*)(gk0 + (size_t)(kt) * 64 * 576); if (hask1) k1r = *(const uint4*)(gk1 + (size_t)(kt) * 64 * 576); } while (0)
#define VLOAD(kt) do { v0r = *(const uint4*)(gv0 + (size_t)(kt) * 64 * 384); } while (0)
#define KSTORE(buf) do { *(uint4*)(lk0 + (buf) * 64 * KP) = k0r; if (hask1) *(uint4*)(lk1 + (buf) * 64 * KP) = k1r; } while (0)
#define VSTORE(buf) do { *(uint4*)(lv0 + (buf) * 64 * VP) = v0r; } while (0)
  KLOAD(0); VLOAD(0);
  KSTORE(0); VSTORE(0);
  KLOAD(1);
  KSTORE(1);
  __syncthreads();
  f32x16 sc[2];
  qk_tile<96>(qf, shm, KP, sc, lane);
#pragma unroll 1
  for (int kt = 0; kt < 64; ++kt) {
    const int cur = kt & 1;
    if (kt + 2 < 64) KLOAD(kt + 2);
    if (kt + 1 < 64) VLOAD(kt + 1);
    f32x16 sn[2];
    qk_tile<96>(qf, shm + (cur ^ 1) * 64 * KP, KP, sn, lane);
    softmax_pv<64>(sc, shm + 2 * 64 * KP + cur * 64 * VP, VP, o, m, lsum, [&](int, float v) { return v; }, lane);
    if (kt + 2 < 64) KSTORE(cur);
    if (kt + 1 < 64) VSTORE(cur ^ 1);
    __syncthreads();
#pragma unroll
    for (int sub = 0; sub < 2; ++sub) sc[sub] = sn[sub];
  }
#undef KLOAD
#undef VLOAD
#undef KSTORE
#undef VSTORE
  const float inv = 1.f / lsum;
#pragma unroll
  for (int mt = 0; mt < 2; ++mt)
#pragma unroll
    for (int g4 = 0; g4 < 4; ++g4) {
      const int dv0 = mt * 32 + 8 * g4 + 4 * h;
      const uint2 gg = *(const uint2*)(p + qrow * INW + C_DG + hh * 64 + dv0);
      uint2 ov;
      ov.x = pack2(o[mt][4 * g4] * inv * bf2f(gg.x & 0xffff), o[mt][4 * g4 + 1] * inv * bf2f(gg.x >> 16));
      ov.y = pack2(o[mt][4 * g4 + 2] * inv * bf2f(gg.y & 0xffff), o[mt][4 * g4 + 3] * inv * bf2f(gg.y >> 16));
      *(uint2*)(Y + qrow * YW + Y_D + hh * 64 + dv0) = ov;
    }
}

DI void phase_prep(const Params& P, int l, int coff = 0, int im = IM) {
  unsigned* ctr = (unsigned*)(P.ws + OFF_CTR) + (l * 2 + 0) + coff;
  constexpr int N_D = 384, N_B = 1536, N_A = 1152;
  for (;;) {
    const int item = next_item(ctr);
    if (item >= N_D + N_B + N_A) break;
    if (item < 192) { if (im & 1) dprep_item<true>(P, l, item); }
    else if (item < N_D) { if (im & 1) dprep_item<false>(P, l, item - 192); }
    else if (item < N_D + N_B) { if (im & 2) b_item(P, l, item - N_D, 0); }
    else { if (im & 4) a_attn_item(P, item - N_D - N_B); }
  }
}
DI void phase_attn(const Params& P, int l, int coff = 0, int im = IM) {
  unsigned* ctr = (unsigned*)(P.ws + OFF_CTR) + (l * 2 + 1) + coff;
  constexpr int N_C = 512, N_D = 384, N_B = 1536, N_A = 128;
  for (;;) {
    const int item = next_item(ctr);
    if (item >= N_C + N_D + N_B + N_A) break;
    if (item < N_C) { if (im & 8) c_attn_item(P, l, item); }
    else if (item < N_C + N_D) { if (im & 16) d_attn_item(P, item - N_C); }
    else if (item < N_C + N_D + N_B) { if (im & 32) b_item(P, l, item - N_C - N_D, 1); }
    else { if (im & 64) a_combine_item(P, item - N_C - N_D - N_B); }
  }
}

DI void phase_merge(const Params& P, int l) {
  const u16* p = (const u16*)(P.ws + OFF_P);
  const u16* Y = (const u16*)(P.ws + OFF_Y);
  const u16* wT = (const u16*)(P.ws + OFF_WBRT) + (size_t)l * 1024 * YW;
  u16* mrg = (u16*)(P.ws + OFF_HB);
  const int tid = otid(), wid = tid >> 6, lane = tid & 63, wr = wid >> 2, wc = wid & 3, fr = lane & 15, fq = lane >> 4;
  for (int t = blockIdx.x; t < 64 * 8; t += gridDim.x) {
    const int pn = t & 7, pm = t >> 3;
    f32x4 mg[8][2];
#pragma unroll
    for (int m = 0; m < 8; ++m)
#pragma unroll
      for (int n = 0; n < 2; ++n) mg[m][n] = f32x4{0.f, 0.f, 0.f, 0.f};
#pragma unroll 1
    for (int br = 0; br < 4; ++br) {
      const int koff = (br == 0) ? Y_A : (br == 1 ? Y_B : (br == 2 ? Y_C : Y_D));
      const int nk = (br == 2) ? 8 : 6;
      f32x4 acc[8][2];
#pragma unroll
      for (int m = 0; m < 8; ++m)
#pragma unroll
        for (int n = 0; n < 2; ++n) acc[m][n] = f32x4{0.f, 0.f, 0.f, 0.f};
      gemm_tile<2>(Y + (size_t)pm * 256 * YW + koff, YW, wT + (size_t)pn * 128 * YW + koff, YW, nk, acc);
#pragma unroll
      for (int m = 0; m < 8; ++m)
#pragma unroll
        for (int n = 0; n < 2; ++n) {
          const size_t row = (size_t)pm * 256 + wr * 128 + m * 16 + fr;
          const int col = pn * 128 + wc * 32 + n * 16 + fq * 4;
          const uint2 g = *(const uint2*)(p + row * INW + C_GATE + br * 1024 + col);
          mg[m][n][0] += bf2f(g.x & 0xffff) * acc[m][n][0];
          mg[m][n][1] += bf2f(g.x >> 16) * acc[m][n][1];
          mg[m][n][2] += bf2f(g.y & 0xffff) * acc[m][n][2];
          mg[m][n][3] += bf2f(g.y >> 16) * acc[m][n][3];
        }
    }
#pragma unroll
    for (int m = 0; m < 8; ++m)
#pragma unroll
      for (int n = 0; n < 2; ++n) {
        const size_t row = (size_t)pm * 256 + wr * 128 + m * 16 + fr;
        const int col = pn * 128 + wc * 32 + n * 16 + fq * 4;
        *(uint2*)(mrg + row * DM + col) = uint2{pack2(mg[m][n][0], mg[m][n][1]), pack2(mg[m][n][2], mg[m][n][3])};
      }
  }
}

DI void phase_outproj(const Params& P, int l) {
  const u16* mrg = (const u16*)(P.ws + OFF_HB);
  const u16* wT = (const u16*)(P.ws + OFF_WOUTT) + (size_t)l * DM * DM;
  float* oraw = (float*)(P.ws + OFF_P);
  const int tid = otid(), wid = tid >> 6, lane = tid & 63, wr = wid >> 2, wc = wid & 3, fr = lane & 15, fq = lane >> 4;
  for (int t = blockIdx.x; t < 64 * 4; t += gridDim.x) {
    const int pn = t & 3, pm = t >> 2;
    f32x4 acc[8][4];
#pragma unroll
    for (int m = 0; m < 8; ++m)
#pragma unroll
      for (int n = 0; n < 4; ++n) acc[m][n] = f32x4{0.f, 0.f, 0.f, 0.f};
    gemm_tile<4>(mrg + (size_t)pm * 256 * DM, DM, wT + (size_t)pn * 256 * DM, DM, DM / 64, acc);
#pragma unroll
    for (int m = 0; m < 8; ++m)
#pragma unroll
      for (int n = 0; n < 4; ++n)
      {
          const size_t row = (size_t)pm * 256 + wr * 128 + m * 16 + fr;
          const int col = pn * 256 + wc * 64 + n * 16 + fq * 4;
          *(float4*)(oraw + row * DM + col) = float4{acc[m][n][0], acc[m][n][1], acc[m][n][2], acc[m][n][3]};
        }
  }
}

__global__ void __launch_bounds__(512, 2) mixer_megakernel(Params P) {
  cg::grid_group grid = cg::this_grid();
  for (int ph = P.phase_lo; ph < P.phase_hi; ++ph) {
    if (ph > P.phase_lo) grid.sync();
#ifndef ONLY
#define ONLY -1
#endif
    if (ph == 0) { if (ONLY<0||ONLY==0) phase_prologue(P); continue; }
    if (ph == NPHASE - 1) { if (ONLY<0||ONLY==1) phase_norm(P, DEPTH); continue; }
    const int l = (ph - 1) / 6, s = (ph - 1) % 6;
#ifdef REP
    if (s == REP) {
      switch (s) {
        case 1: phase_inproj(P, l); break;
        case 2: phase_prep(P, l, 16, REPIM); break;
        case 3: phase_attn(P, l, 16, REPIM); break;
        case 4: phase_merge(P, l); break;
        case 5: phase_outproj(P, l); break;
      }
      grid.sync();
    }
#endif
    switch (s) {
      case 0: if (ONLY<0||ONLY==1) phase_norm(P, l); break;
      case 1: if (ONLY<0||ONLY==2) phase_inproj(P, l); break;
      case 2: if (ONLY<0||ONLY==3) phase_prep(P, l); break;
      case 3: if (ONLY<0||ONLY==4) phase_attn(P, l); break;
      case 4: if (ONLY<0||ONLY==5) phase_merge(P, l); break;
      default: if (ONLY<0||ONLY==6) phase_outproj(P, l); break;
    }
  }
}

extern "C" void kernel_launch(void* const* d_in, const int* in_sizes, int n_in, void* d_out, int out_size, void* d_ws,
                              size_t ws_size, hipStream_t stream) {
  (void)in_sizes; (void)n_in; (void)out_size;
  if (ws_size < WS_NEED) { fprintf(stderr, "workspace too small: %zu < %zu\n", ws_size, WS_NEED); return; }
  Params P{};
  const float** f = (const float**)&P;
  for (int i = 0; i < 26; ++i) f[i] = (const float*)d_in[i];
  P.out = (float*)d_out;
  P.ws = (char*)d_ws;
  for (int i = 0; i < 16; ++i) P.inv[i] = std::pow(10000.0, -(double)i / 16.0);
  hipMemsetAsync(d_ws, 0, 4096, stream);
#if ONE_LAUNCH
  static int grid_blocks = 0;
  if (!grid_blocks) {
    int dev = 0, cus = 0, per_cu = 0;
    hipGetDevice(&dev);
    hipDeviceGetAttribute(&cus, hipDeviceAttributeMultiprocessorCount, dev);
    hipOccupancyMaxActiveBlocksPerMultiprocessor(&per_cu, mixer_megakernel, 512, 0);
    if (per_cu < 1) per_cu = 1;
    grid_blocks = cus * per_cu;
  }
  P.phase_lo = 0;
  P.phase_hi = NPHASE;
  void* args[] = {&P};
  hipError_t e = hipLaunchCooperativeKernel((void*)mixer_megakernel, dim3(grid_blocks), dim3(512), args, 0, stream);
  if (e != hipSuccess) fprintf(stderr, "cooperative launch failed: %s (grid %d)\n", hipGetErrorString(e), grid_blocks);
#else
  for (int ph = 0; ph < NPHASE; ++ph) {
    P.phase_lo = ph;
    P.phase_hi = ph + 1;
    hipLaunchKernelGGL(mixer_megakernel, dim3(256), dim3(512), 0, stream, P);
  }
#endif
}
```
